# Optimizing an MI355X kernel written in HIP

```python
import jax, jax.numpy as jnp
from jax import lax
import numpy as np

D_MODEL = 1024
BATCH = 2
SEQ = 8192
DEPTH = 1
DEC_BATCH = 32
DEC_SEQ = 64
PAST_LEN = 1024

CHUNK = 64
N_HEADS = 8
N_KV_HEADS = 2
HEAD_DIM = 64
GROUP = N_HEADS // N_KV_HEADS
IDX_HEADS = 8
IDX_DIM = 64
TOPK_MAX = 256
Q_BLOCK = 128
CONV_CH = 512
CONV_WIDTH = 31
D_FF = 2816
ROPE_THETA = 10000.0
EPS = 1e-6

Q_COLS = N_HEADS * HEAD_DIM
KV_COLS = N_KV_HEADS * HEAD_DIM
IDXQ_COLS = IDX_HEADS * IDX_DIM
GATE_COLS = 2 * D_MODEL
SPLIT_SIZES = (Q_COLS, KV_COLS, KV_COLS, IDXQ_COLS, IDX_DIM, IDX_HEADS, 2 * CONV_CH, GATE_COLS)
IN_COLS = sum(SPLIT_SIZES)

kernel_name = "dsa_conformer_gated_streaming_step"


def _rms(x, g):
    x32 = x.astype(jnp.float32)
    y = x32 * lax.rsqrt(jnp.mean(x32 * x32, axis=-1, keepdims=True) + EPS)
    return (y * g.astype(jnp.float32)).astype(x.dtype)


def _layernorm(x, g, b):
    x32 = x.astype(jnp.float32)
    mu = jnp.mean(x32, axis=-1, keepdims=True)
    var = jnp.mean(jnp.square(x32 - mu), axis=-1, keepdims=True)
    y = (x32 - mu) * lax.rsqrt(var + EPS)
    return (y * g.astype(jnp.float32) + b.astype(jnp.float32)).astype(x.dtype)


def _rope(x, pos):
    d = x.shape[-1]
    inv = ROPE_THETA ** (-jnp.arange(0, d, 2, dtype=jnp.float32) / d)
    ang = pos.astype(jnp.float32)[:, None] * inv[None, :]
    cos = jnp.cos(ang)[None, :, None, :]
    sin = jnp.sin(ang)[None, :, None, :]
    x32 = x.astype(jnp.float32)
    x1, x2 = x32[..., : d // 2], x32[..., d // 2:]
    out = jnp.concatenate([x1 * cos - x2 * sin, x2 * cos + x1 * sin], axis=-1)
    return out.astype(x.dtype)


def _swiglu(x, g, w_in, w_out):
    a, b = jnp.split(_rms(x, g) @ w_in, 2, axis=-1)
    return (jax.nn.silu(a) * b) @ w_out


def _dsa_attention(q, k, v, q_idx, k_idx, w_idx, q_pos):
    B, T = q.shape[0], q.shape[1]
    L = k.shape[1]
    top = min(TOPK_MAX, L // 4)
    qb = min(Q_BLOCK, T)
    nb = T // qb
    key_pos = jnp.arange(L, dtype=jnp.int32)

    def blocks(a):
        return jnp.moveaxis(a.reshape((B, nb, qb) + a.shape[2:]), 1, 0)

    def one_block(args):
        qq, qi, wi, pos = args
        limit = (pos // CHUNK + 1) * CHUNK
        admissible = key_pos[None, :] < limit[:, None]
        s = jnp.einsum('bqhd,bsd->bqhs', qi, k_idx).astype(jnp.float32)
        score = jnp.einsum('bqh,bqhs->bqs', wi.astype(jnp.float32), jax.nn.relu(s))
        score = jnp.where(admissible[None], score, -jnp.inf)
        _, sel = lax.top_k(score, top)
        valid = sel < limit[None, :, None]
        kg = jax.vmap(lambda kb, ib: kb[ib])(k, sel)
        vg = jax.vmap(lambda vb, ib: vb[ib])(v, sel)
        qg = qq.reshape(B, qb, N_KV_HEADS, GROUP, HEAD_DIM)
        logits = jnp.einsum('bqcgd,bqncd->bqcgn', qg, kg).astype(jnp.float32) * (HEAD_DIM ** -0.5)
        logits = jnp.where(valid[:, :, None, None, :], logits, -jnp.inf)
        p = jax.nn.softmax(logits, axis=-1).astype(vg.dtype)
        o = jnp.einsum('bqcgn,bqncd->bqcgd', p, vg)
        return o.reshape(B, qb, N_HEADS * HEAD_DIM)

    out = lax.map(one_block, (blocks(q), blocks(q_idx), blocks(w_idx), q_pos.reshape(nb, qb)))
    return jnp.moveaxis(out, 0, 1).reshape(B, T, N_HEADS * HEAD_DIM)


def _layer(x, past_k, past_v, past_idx_k, past_conv,
           ffn1_norm, ffn1_w_in, ffn1_w_out, mix_norm, w_in, b_gate,
           conv_w, conv_b, conv_ln_g, conv_ln_b, conv_w_out, attn_w_out, w_out,
           ffn2_norm, ffn2_w_in, ffn2_w_out):
    B, T, _ = x.shape
    P = past_k.shape[1]
    pos = P + jnp.arange(T, dtype=jnp.int32)

    h = x + 0.5 * _swiglu(x, ffn1_norm, ffn1_w_in, ffn1_w_out)
    u = _rms(h, mix_norm)
    z = u @ w_in
    points = np.cumsum(SPLIT_SIZES)[:-1].tolist()
    q, k, v, qi, ki, wi, conv_in, gate = jnp.split(z, points, axis=-1)

    q = _rope(q.reshape(B, T, N_HEADS, HEAD_DIM), pos)
    k = _rope(k.reshape(B, T, N_KV_HEADS, HEAD_DIM), pos)
    v = v.reshape(B, T, N_KV_HEADS, HEAD_DIM)
    qi = _rope(qi.reshape(B, T, IDX_HEADS, IDX_DIM), pos)
    ki = _rope(ki.reshape(B, T, 1, IDX_DIM), pos)[:, :, 0]
    wi = wi * (IDX_HEADS ** -0.5)
    k_all = jnp.concatenate([past_k, k], axis=1)
    v_all = jnp.concatenate([past_v, v], axis=1)
    ki_all = jnp.concatenate([past_idx_k, ki], axis=1)
    attn = _dsa_attention(q, k_all, v_all, qi, ki_all, wi, pos)

    ca, cb = jnp.split(conv_in, 2, axis=-1)
    c = ca * jax.nn.sigmoid(cb)
    c_pad = jnp.concatenate([past_conv, c], axis=1)
    dc = lax.conv_general_dilated(c_pad, conv_w[:, None, :], window_strides=(1,), padding='VALID',
                                  dimension_numbers=('NWC', 'WIO', 'NWC'),
                                  feature_group_count=CONV_CH) + conv_b
    conv_out = jax.nn.silu(_layernorm(dc, conv_ln_g, conv_ln_b)) @ conv_w_out

    g_a, g_c = jnp.split(jax.nn.sigmoid(gate + b_gate), 2, axis=-1)
    merged = g_a * (attn @ attn_w_out) + g_c * conv_out
    h = h + merged @ w_out
    h = h + 0.5 * _swiglu(h, ffn2_norm, ffn2_w_in, ffn2_w_out)
    return h, k, v, ki, c_pad[:, -(CONV_WIDTH - 1):]


def setup_inputs(seed: int = 0) -> dict:
    key = jax.random.key(seed)
    ks = jax.random.split(key, 32)
    f32 = jnp.float32

    def nrm(i, shape, scale):
        return jax.random.normal(ks[i], shape, f32) * scale

    def gain(i, shape):
        return 1.0 + 0.02 * jax.random.normal(ks[i], shape, f32)

    return {
        "x_prompt": nrm(0, (BATCH, SEQ, D_MODEL), 1.0),
        "x_sample": nrm(1, (DEC_BATCH, DEC_SEQ, D_MODEL), 1.0),
        "cache_k": nrm(2, (DEPTH, DEC_BATCH, PAST_LEN, N_KV_HEADS, HEAD_DIM), 1.0),
        "cache_v": nrm(3, (DEPTH, DEC_BATCH, PAST_LEN, N_KV_HEADS, HEAD_DIM), 1.0),
        "cache_idx_k": nrm(4, (DEPTH, DEC_BATCH, PAST_LEN, IDX_DIM), 1.0),
        "state_conv": nrm(5, (DEPTH, DEC_BATCH, CONV_WIDTH - 1, CONV_CH), 0.5),
        "ffn1_norm": gain(6, (DEPTH, D_MODEL)),
        "ffn1_w_in": nrm(7, (DEPTH, D_MODEL, 2 * D_FF), D_MODEL ** -0.5),
        "ffn1_w_out": nrm(8, (DEPTH, D_FF, D_MODEL), D_FF ** -0.5),
        "mix_norm": gain(9, (DEPTH, D_MODEL)),
        "w_in": nrm(10, (DEPTH, D_MODEL, IN_COLS), D_MODEL ** -0.5),
        "b_gate": nrm(11, (DEPTH, GATE_COLS), 0.01),
        "conv_w": nrm(12, (DEPTH, CONV_WIDTH, CONV_CH), CONV_WIDTH ** -0.5),
        "conv_b": nrm(13, (DEPTH, CONV_CH), 0.01),
        "conv_ln_g": gain(14, (DEPTH, CONV_CH)),
        "conv_ln_b": nrm(15, (DEPTH, CONV_CH), 0.01),
        "conv_w_out": nrm(16, (DEPTH, CONV_CH, D_MODEL), CONV_CH ** -0.5),
        "attn_w_out": nrm(17, (DEPTH, Q_COLS, D_MODEL), Q_COLS ** -0.5),
        "w_out": nrm(18, (DEPTH, D_MODEL, D_MODEL), D_MODEL ** -0.5),
        "ffn2_norm": gain(19, (DEPTH, D_MODEL)),
        "ffn2_w_in": nrm(20, (DEPTH, D_MODEL, 2 * D_FF), D_MODEL ** -0.5),
        "ffn2_w_out": nrm(21, (DEPTH, D_FF, D_MODEL), D_FF ** -0.5),
        "final_norm": gain(22, (D_MODEL,)),
    }


def reference(x_prompt, x_sample, cache_k, cache_v, cache_idx_k, state_conv,
              ffn1_norm, ffn1_w_in, ffn1_w_out, mix_norm, w_in, b_gate,
              conv_w, conv_b, conv_ln_g, conv_ln_b, conv_w_out, attn_w_out, w_out,
              ffn2_norm, ffn2_w_in, ffn2_w_out, final_norm):
    hp, hs = x_prompt, x_sample
    Bp = x_prompt.shape[0]
    dt = x_prompt.dtype
    kp_l, vp_l, ip_l, cp_l = [], [], [], []
    ks_l, vs_l, is_l, cs_l = [], [], [], []
    for l in range(DEPTH):
        w = (ffn1_norm[l], ffn1_w_in[l], ffn1_w_out[l], mix_norm[l], w_in[l], b_gate[l],
             conv_w[l], conv_b[l], conv_ln_g[l], conv_ln_b[l], conv_w_out[l], attn_w_out[l], w_out[l],
             ffn2_norm[l], ffn2_w_in[l], ffn2_w_out[l])
        hp, kp, vp, ip, cp = _layer(
            hp,
            jnp.zeros((Bp, 0, N_KV_HEADS, HEAD_DIM), dt),
            jnp.zeros((Bp, 0, N_KV_HEADS, HEAD_DIM), dt),
            jnp.zeros((Bp, 0, IDX_DIM), dt),
            jnp.zeros((Bp, CONV_WIDTH - 1, CONV_CH), dt),
            *w)
        hs, ks_, vs_, is_, cs_ = _layer(hs, cache_k[l], cache_v[l], cache_idx_k[l], state_conv[l], *w)
        kp_l.append(kp); vp_l.append(vp); ip_l.append(ip); cp_l.append(cp)
        ks_l.append(ks_); vs_l.append(vs_); is_l.append(is_); cs_l.append(cs_)
    y_prompt = _rms(hp, final_norm)
    y_sample = _rms(hs, final_norm)
    return (y_prompt, y_sample,
            jnp.stack(kp_l), jnp.stack(vp_l), jnp.stack(ip_l), jnp.stack(cp_l),
            jnp.stack(ks_l), jnp.stack(vs_l), jnp.stack(is_l), jnp.stack(cs_l))
```

```cpp
#include <hip/hip_runtime.h>
#include <hip/hip_cooperative_groups.h>
#include <cstdio>
#include <cstdint>
#include <cmath>
namespace cg = cooperative_groups;
namespace pg8 {
#define PG8_LAS __attribute__((address_space(3)))
typedef unsigned short bf16_t;
typedef short bf16x8 __attribute__((ext_vector_type(8)));
typedef float f32x4 __attribute__((ext_vector_type(4)));
typedef unsigned u32x4 __attribute__((ext_vector_type(4)));
constexpr int BM = 256, BK = 64, HALF = 128, HTB = HALF * BK * 2  , STAGE_BYTES = 8 * HTB, NXCD = 8, WGM = 8;

__host__ __device__ __forceinline__ int lds_byte(int r, int c) { const int st = (r >> 4) * 2 + (c >> 5), rr = r & 15, cc = c & 31, ob = rr * 64 + cc * 2; return st * 1024 + (ob ^ (((ob >> 9) & 1) << 5)); }
__host__ __device__ __forceinline__ void stage_rc(int b, int& R, int& C) { const int st = b / 1024, sb = b % 1024, swz = sb ^ (((sb >> 9) & 1) << 5); R = (st >> 1) * 16 + swz / 64; C = (st & 1) * 32 + (swz % 64) / 2; }
__host__ __device__ __forceinline__ int perm32(int rho) { const int n = rho >> 4, i = rho & 15; return 8 * (i >> 2) + 4 * n + (i & 3); }


struct Unit { int pm, pn, z; };
struct Gemm { const bf16_t* A; const bf16_t* Bt; const bf16_t* A2; const bf16_t* Bt2; int M, N, K; };

struct StaticOrder {
    int nM, nN, nwg, G, c, dbl;
    __host__ __device__ void init(int M, int N, int G_, int c_, int dbl_) { nM = M / BM; nN = N / BM; nwg = nM * nN; G = G_; c = c_; dbl = dbl_; }
    __host__ __device__ bool next(int i, Unit& u) const {
        const int ii = dbl ? (i >> 1) : i;
        const long L = (long)ii * G + c; if (L >= nwg) return false;
        int wgid = (int)L; { const int q = nwg / NXCD, r = nwg % NXCD, xcd = wgid % NXCD, off = wgid / NXCD; wgid = (xcd < r ? xcd * (q + 1) : r * (q + 1) + (xcd - r) * q) + off; }
        const int nig = WGM * nN, gid = wgid / nig, fm = gid * WGM, gsz = (nM - fm) < WGM ? (nM - fm) : WGM;
        u.pm = fm + ((wgid % nig) % gsz); u.pn = (wgid % nig) / gsz; u.z = dbl ? (i & 1) : 0; return true;
    }
    __device__ __forceinline__ void a_ready(const Unit&) const {}
    __device__ __forceinline__ void done(const Unit&) const {}
};

struct XcdOrder {
    int nN, T, xi, nx, nloc, r, dbl;
    __device__ void init(int M, int N, int xi_, int nx_, int nloc_, int r_, int dbl_) { const int nM = M / BM; nN = N / BM; xi = xi_; nx = nx_; nloc = nloc_; r = r_; dbl = dbl_; T = (nM - xi + nx - 1) / nx; }
    __device__ bool next(int i, Unit& u) const {
        const int ii = dbl ? (i >> 1) : i;
        const int j = ii * nloc + r; if (j >= T * nN) return false;
        u.pn = j / T; u.pm = xi + nx * (j - u.pn * T); u.z = dbl ? (i & 1) : 0; return true;
    }
    __device__ __forceinline__ void a_ready(const Unit&) const {}
    __device__ __forceinline__ void done(const Unit&) const {}
};
typedef float f32x2_t_ __attribute__((ext_vector_type(2)));
typedef __bf16 bf16x2_t_ __attribute__((ext_vector_type(2)));
__device__ __forceinline__ unsigned cvt_pk_bf16(float lo, float hi) { const f32x2_t_ v = {lo, hi}; const bf16x2_t_ b = __builtin_convertvector(v, bf16x2_t_); return __builtin_bit_cast(unsigned, b); }

template <class Epi, class Sched, bool ALIGN_EPI = false, bool SP2 = false>
__device__ __forceinline__ void gemm_phase(PG8_LAS unsigned char* lds, const Gemm g, const Sched& S, const Epi& E) {
    int tid_ = threadIdx.x; asm volatile("" : "+v"(tid_));
    const int tid = tid_, wid = __builtin_amdgcn_readfirstlane(tid >> 6), lane = tid & 63, wr = wid >> 2, wc = wid & 3, fr = lane & 15, fq = lane >> 4;
    const int K = g.K, nt = K / BK;
    unsigned voffA[2], voffB[2];
#pragma unroll
    for (int i = 0; i < 2; ++i) { int R, C; stage_rc(tid * 16 + i * 8192, R, C); const int Rb = Epi::PERM ? ((R & ~31) + perm32(R & 31)) : R;
        voffA[i] = (unsigned)(R * K + C) * 2u; voffB[i] = (unsigned)(Rb * K + C) * 2u; }
    const size_t kstep = (size_t)(BK * 2);
    const size_t hstep = (size_t)HALF * K * 2;
    const size_t tstep = 2 * hstep;
    const unsigned ldsw = (unsigned)wid * 1024u;
    const int aoff = lds_byte(wr * 64 + fr, fq * 8), boff = lds_byte(wc * 32 + fr, fq * 8);
#define PG8_SA(b, h) (((b) * 2 + (h)) * HTB)
#define PG8_SB(b, h) ((4 + (b) * 2 + (h)) * HTB)
#define PG8_STAGE(bufoff, gbase, voff) do { _Pragma("unroll") for (int _i = 0; _i < 2; ++_i) \
        __builtin_amdgcn_global_load_lds((const unsigned*)((const char*)(gbase) + (voff)[_i]), (PG8_LAS unsigned*)(lds + (bufoff) + ldsw + _i * 8192), 16, 0, 0); } while (0)
#define PG8_LDA(dst, b, h) do { _Pragma("unroll") for (int m = 0; m < 4; ++m) _Pragma("unroll") for (int k = 0; k < 2; ++k) dst[m][k] = *(const PG8_LAS bf16x8*)(lds + PG8_SA(b, h) + aoff + m * 2048 + k * 1024); } while (0)
#define PG8_LDB(dst, b, h) do { _Pragma("unroll") for (int n = 0; n < 2; ++n) _Pragma("unroll") for (int k = 0; k < 2; ++k) dst[n][k] = *(const PG8_LAS bf16x8*)(lds + PG8_SB(b, h) + boff + n * 2048 + k * 1024); } while (0)
#define PG8_MMA(ai, bj, At, Bt) do { __builtin_amdgcn_s_setprio(1); _Pragma("unroll") for (int m = 0; m < 4; ++m) _Pragma("unroll") for (int n = 0; n < 2; ++n) _Pragma("unroll") for (int k = 0; k < 2; ++k) \
        acc[ai][bj][m][n] = __builtin_amdgcn_mfma_f32_16x16x32_bf16(Bt[n][k], At[m][k], acc[ai][bj][m][n], 0, 0, 0); __builtin_amdgcn_s_setprio(0); } while (0)
#define PG8_WAIT_V(n) asm volatile("s_waitcnt vmcnt(" #n ")" ::: "memory")
#define PG8_WAIT_L(n) asm volatile("s_waitcnt lgkmcnt(" #n ")" ::: "memory")
#define PG8_BAR __builtin_amdgcn_s_barrier()
#define PG8_SCHED __builtin_amdgcn_sched_barrier(0)
    Unit cur, nxt; int ui = 0;
    if (!S.next(0, cur)) return;
    f32x4 acc[2][2][4][2];
#pragma unroll
    for (int a = 0; a < 2; ++a)
#pragma unroll
        for (int b = 0; b < 2; ++b)
#pragma unroll
            for (int m = 0; m < 4; ++m)
#pragma unroll
                for (int n = 0; n < 2; ++n) acc[a][b][m][n] = (f32x4){0.f, 0.f, 0.f, 0.f};
    bf16x8 At[4][2], B0[2][2], B1[2][2];
    const char* cA = (const char*)(cur.z ? g.A2 : g.A) + (size_t)cur.pm * tstep; const char* cB = (const char*)(cur.z ? g.Bt2 : g.Bt) + (size_t)cur.pn * tstep;
    S.a_ready(cur);
    if constexpr (SP2) {
        PG8_STAGE(PG8_SB(0, 0), cB, voffB); PG8_STAGE(PG8_SB(0, 1), cB + hstep, voffB); PG8_STAGE(PG8_SA(0, 0), cA, voffA); PG8_STAGE(PG8_SA(0, 1), cA + hstep, voffA);
        if (wr == 1) PG8_BAR;
        PG8_WAIT_V(2); PG8_BAR;
        PG8_STAGE(PG8_SB(1, 0), cB + kstep, voffB); PG8_STAGE(PG8_SA(1, 0), cA + kstep, voffA); PG8_STAGE(PG8_SB(1, 1), cB + hstep + kstep, voffB);
        PG8_WAIT_V(6); PG8_BAR;
    } else {
        PG8_STAGE(PG8_SB(0, 0), cB, voffB); PG8_STAGE(PG8_SA(0, 0), cA, voffA); PG8_STAGE(PG8_SB(0, 1), cB + hstep, voffB); PG8_STAGE(PG8_SA(0, 1), cA + hstep, voffA);
        if (wr == 1) PG8_BAR;
        PG8_WAIT_V(4); PG8_BAR;
        PG8_STAGE(PG8_SB(1, 0), cB + kstep, voffB); PG8_STAGE(PG8_SA(1, 0), cA + kstep, voffA); PG8_STAGE(PG8_SB(1, 1), cB + hstep + kstep, voffB);
        PG8_WAIT_V(6); PG8_BAR;
    }
    for (;;) {
        const bool has_next = S.next(ui + 1, nxt);
        const char* nA = has_next ? (const char*)(nxt.z ? g.A2 : g.A) + (size_t)nxt.pm * tstep : cA; const char* nB = has_next ? (const char*)(nxt.z ? g.Bt2 : g.Bt) + (size_t)nxt.pn * tstep : cB;
        for (int t = 0; t < nt; t += 2) {
            const bool last = (t == nt - 2);
            const char* a1 = cA + (size_t)(t + 1) * kstep;
            const char* a2 = last ? nA : cA + (size_t)(t + 2) * kstep; const char* b2 = last ? nB : cB + (size_t)(t + 2) * kstep;
            const char* a3 = a2 + kstep; const char* b3 = b2 + kstep;
            if (last && has_next) S.a_ready(nxt);
            if constexpr (SP2) {
            PG8_LDB(B0, 0, 0); PG8_LDB(B1, 0, 1); PG8_SCHED; PG8_LDA(At, 0, 0); PG8_STAGE(PG8_SA(1, 1), a1 + hstep, voffA);
            PG8_WAIT_V(8); PG8_WAIT_L(0); PG8_BAR; PG8_MMA(0, 0, At, B0); PG8_MMA(0, 1, At, B1); PG8_BAR; PG8_SCHED;
            PG8_LDA(At, 0, 1); PG8_STAGE(PG8_SB(0, 0), b2, voffB); PG8_STAGE(PG8_SB(0, 1), b2 + hstep, voffB); PG8_STAGE(PG8_SA(0, 0), a2, voffA);
            PG8_WAIT_V(8); PG8_WAIT_L(0); PG8_BAR; PG8_MMA(1, 0, At, B0); PG8_MMA(1, 1, At, B1); PG8_BAR; PG8_SCHED;
            PG8_LDB(B0, 1, 0); PG8_LDB(B1, 1, 1); PG8_SCHED; PG8_LDA(At, 1, 0); PG8_STAGE(PG8_SA(0, 1), a2 + hstep, voffA);
            PG8_WAIT_V(8); PG8_WAIT_L(0); PG8_BAR; PG8_MMA(0, 0, At, B0); PG8_MMA(0, 1, At, B1); PG8_BAR; PG8_SCHED;
            PG8_LDA(At, 1, 1); PG8_STAGE(PG8_SB(1, 0), b3, voffB); PG8_STAGE(PG8_SB(1, 1), b3 + hstep, voffB); PG8_STAGE(PG8_SA(1, 0), a3, voffA);
            PG8_WAIT_V(8); PG8_WAIT_L(0); PG8_BAR; PG8_MMA(1, 0, At, B0); PG8_MMA(1, 1, At, B1); PG8_BAR; PG8_SCHED;
            } else {
            PG8_LDB(B0, 0, 0); PG8_SCHED; PG8_LDA(At, 0, 0); PG8_STAGE(PG8_SA(1, 1), a1 + hstep, voffA);
            PG8_WAIT_L(8); PG8_BAR; PG8_WAIT_L(0); PG8_MMA(0, 0, At, B0); PG8_BAR; PG8_SCHED;
            PG8_LDB(B1, 0, 1); PG8_STAGE(PG8_SB(0, 0), b2, voffB);
            PG8_BAR; PG8_WAIT_L(0); PG8_MMA(0, 1, At, B1); PG8_BAR;
            PG8_LDA(At, 0, 1); PG8_STAGE(PG8_SA(0, 0), a2, voffA);
            PG8_BAR; PG8_WAIT_L(0); PG8_MMA(1, 0, At, B0); PG8_BAR; PG8_SCHED;
            PG8_STAGE(PG8_SB(0, 1), b2 + hstep, voffB);
            PG8_WAIT_V(6); PG8_BAR; PG8_MMA(1, 1, At, B1); PG8_BAR;
            PG8_LDB(B0, 1, 0); PG8_SCHED; PG8_LDA(At, 1, 0); PG8_STAGE(PG8_SA(0, 1), a2 + hstep, voffA);
            PG8_WAIT_L(8); PG8_BAR; PG8_WAIT_L(0); PG8_MMA(0, 0, At, B0); PG8_BAR; PG8_SCHED;
            PG8_LDB(B1, 1, 1); PG8_STAGE(PG8_SB(1, 0), b3, voffB);
            PG8_BAR; PG8_WAIT_L(0); PG8_MMA(0, 1, At, B1); PG8_BAR;
            PG8_LDA(At, 1, 1); PG8_STAGE(PG8_SA(1, 0), a3, voffA);
            PG8_BAR; PG8_WAIT_L(0); PG8_MMA(1, 0, At, B0); PG8_BAR; PG8_SCHED;
            PG8_STAGE(PG8_SB(1, 1), b3 + hstep, voffB);
            PG8_WAIT_V(6); PG8_BAR; PG8_MMA(1, 1, At, B1); PG8_BAR;
            }
        }
        if constexpr (ALIGN_EPI) { if (wr == 0) PG8_BAR; }
        if constexpr (!Epi::AFTER_DRAIN) { PG8_WAIT_V(0); E(acc, cur, wr, wc, fr, fq); PG8_WAIT_V(0); S.done(cur); }
        if (!has_next) break;
#pragma unroll
        for (int a = 0; a < 2; ++a)
#pragma unroll
            for (int b = 0; b < 2; ++b)
#pragma unroll
                for (int m = 0; m < 4; ++m)
#pragma unroll
                    for (int n = 0; n < 2; ++n) acc[a][b][m][n] = (f32x4){0.f, 0.f, 0.f, 0.f};
        cur = nxt; cA = nA; cB = nB; ++ui;
        if constexpr (ALIGN_EPI) { if (wr == 1) PG8_BAR; }
    }
    PG8_WAIT_V(0);
    if constexpr (!ALIGN_EPI) { if (wr == 0) PG8_BAR; }
    PG8_BAR;
    if constexpr (Epi::AFTER_DRAIN) { E.fused(acc, cur, wr, wc, fr, fq, lds, wid, lane); S.done(cur); }
#undef PG8_SA
#undef PG8_SB
#undef PG8_STAGE
#undef PG8_LDA
#undef PG8_LDB
#undef PG8_MMA
#undef PG8_WAIT_V
#undef PG8_WAIT_L
#undef PG8_BAR
#undef PG8_SCHED
}
}

#define GAS __attribute__((address_space(1)))
#define LAS __attribute__((address_space(3)))
typedef unsigned short bf16;
typedef unsigned v4u __attribute__((ext_vector_type(4)));
typedef unsigned v2u __attribute__((ext_vector_type(2)));
typedef float f32x4 __attribute__((ext_vector_type(4)));
typedef short bf16x8 __attribute__((ext_vector_type(8)));
typedef _Float16 h16x8 __attribute__((ext_vector_type(8)));
using pg8::cvt_pk_bf16;

constexpr int DM = 1024, NTOK = 18432, NPR = 16384, TPR = 8192, TSM = 64, PAST = 1024, LSM = 1088;
constexpr int DFF = 2816, NIN = 4608, NWAVES = 8;
constexpr float EPS = 1e-6f;
constexpr size_t KiB = 1024, MiB = 1u << 20;
constexpr size_t WS_CTL = 0;
constexpr size_t WS_RSTD0 = 64 * KiB;
constexpr size_t WS_WI = 192 * KiB;
constexpr size_t WS_SSQ1 = 768 * KiB;
constexpr size_t WS_SSQ2 = 1920 * KiB;
constexpr size_t WS_SSQ3 = WS_SSQ1;
constexpr size_t WS_HALO_A = 3 * MiB;
constexpr size_t WS_COS = 4 * MiB + 256 * KiB;
constexpr size_t WS_SIN = 5 * MiB + 256 * KiB;
constexpr size_t WS_W1T = 6 * MiB + 256 * KiB;
constexpr size_t WS_W1OT = WS_W1T + 11 * MiB;
constexpr size_t WS_WINT = WS_W1OT + 5 * MiB + 512 * KiB;
constexpr size_t WS_WCOT = WS_WINT + 9 * MiB;
constexpr size_t WS_WAOT = WS_WCOT + 1 * MiB;
constexpr size_t WS_WOT = WS_WAOT + 1 * MiB;
constexpr size_t WS_W2T = WS_WOT + 2 * MiB;
constexpr size_t WS_W2OT = WS_W2T + 11 * MiB;
constexpr size_t WS_XB = WS_W2OT + 5 * MiB + 512 * KiB;
constexpr size_t WS_AO = WS_XB, WS_CA = WS_XB + 18 * MiB;
constexpr size_t WS_ACT = WS_XB + 36 * MiB;
constexpr size_t WS_GATE = WS_ACT, WS_C = WS_ACT + 72 * MiB;
constexpr size_t WS_Q = WS_ACT + 99 * MiB;
constexpr size_t WS_QI = WS_Q + 18 * MiB;
constexpr size_t WS_MERGED = WS_Q;
constexpr size_t WS_KB = WS_QI + 18 * MiB;
constexpr size_t WS_VB = WS_KB + 12 * MiB + 512 * KiB;
constexpr size_t WS_KIB = WS_VB + 12 * MiB + 512 * KiB;
constexpr size_t WS_HALO_B = WS_KIB + 6 * MiB + 256 * KiB;
constexpr size_t WS_END = WS_HALO_B + 1 * MiB;
static_assert(WS_END <= 256 * MiB, "workspace map");
constexpr size_t O_Y = 0, O_KP = 18874368, O_VP = O_KP + 2097152, O_IP = O_VP + 2097152, O_CP = O_IP + 1048576, O_KS = O_CP + 30720,
                 O_VS = O_KS + 262144, O_IS = O_VS + 262144, O_CS = O_IS + 131072, O_END = O_CS + 491520;
constexpr int LDS_BYTES = 147456;
constexpr int CAP = 1024;
constexpr int L_VAL = 0, L_IDX = 65536, L_HIST = 98304, L_CNT = 106496, L_TAU = L_CNT + 64, L_ITEM = L_CNT + 128;

#define LDS_WAIT() asm volatile("s_waitcnt lgkmcnt(0)" ::: "memory")
__device__ __forceinline__ unsigned f2bf(float f) { unsigned u = __builtin_bit_cast(unsigned, f); return (u + 0x7fffu + ((u >> 16) & 1u)) >> 16; }
__device__ __forceinline__ unsigned pk2(float lo, float hi) { return f2bf(lo) | (f2bf(hi) << 16); }
__device__ __forceinline__ unsigned pkh(float lo, float hi) { _Float16 a = (_Float16)lo, b = (_Float16)hi; return (unsigned)__builtin_bit_cast(unsigned short, a) | ((unsigned)__builtin_bit_cast(unsigned short, b) << 16); }
__device__ __forceinline__ float bflo(unsigned v) { return __uint_as_float(v << 16); }
__device__ __forceinline__ float bfhi(unsigned v) { return __uint_as_float(v & 0xffff0000u); }
__device__ __forceinline__ float wave_sum(float v) {
#pragma unroll
    for (int o = 1; o < 64; o <<= 1) v += __shfl_xor(v, o);
    return v;
}
__device__ __forceinline__ float sigmoidf_(float x) { return __builtin_amdgcn_rcpf(1.0f + __expf(-x)); }
__device__ __forceinline__ float siluf_(float x) { return x * sigmoidf_(x); }

struct Args { const float* in[23]; float* out; unsigned char* ws; double invf[32]; };

__device__ __forceinline__ float row_rstd16(const float* ssq, int row) {
    const f32x4* p = (const f32x4*)(ssq + (size_t)row * 16);
    f32x4 a = p[0], b = p[1], c = p[2], d = p[3];
    float s = ((a.x + a.y) + (a.z + a.w)) + ((b.x + b.y) + (b.z + b.w)) + ((c.x + c.y) + (c.z + c.w)) + ((d.x + d.y) + (d.z + d.w));
    return 1.0f / sqrtf(s * (1.0f / 1024.0f) + EPS);
}

struct EpiSwiglu {
    static constexpr bool PERM = true, AFTER_DRAIN = false;
    bf16* act; const float* rstd; const float* ssq;
    __device__ __forceinline__ void operator()(const f32x4 (&acc)[2][2][4][2], const pg8::Unit& u, int wr, int wc, int fr, int fq) const {
        asm volatile("" : "+v"(fr), "+v"(fq));
#pragma unroll
        for (int ai = 0; ai < 2; ++ai)
#pragma unroll
            for (int m = 0; m < 4; ++m) {
                const int row = u.pm * 256 + ai * 128 + wr * 64 + m * 16 + fr;
                const float rs = rstd ? rstd[row] : row_rstd16(ssq, row);
                float o[8];
#pragma unroll
                for (int n = 0; n < 2; ++n)
#pragma unroll
                    for (int j = 0; j < 4; ++j) { const float a = acc[ai][0][m][n][j] * rs, b = acc[ai][1][m][n][j] * rs; o[n * 4 + j] = siluf_(a) * b; }
                v4u w; w.x = cvt_pk_bf16(o[0], o[1]); w.y = cvt_pk_bf16(o[2], o[3]); w.z = cvt_pk_bf16(o[4], o[5]); w.w = cvt_pk_bf16(o[6], o[7]);
                *(v4u*)(act + (size_t)row * DFF + u.pn * 128 + wc * 32 + fq * 8) = w;
            }
    }
};

struct EpiResid {
    static constexpr bool PERM = true, AFTER_DRAIN = false;
    const float* baseP; const float* baseS;
    float* h; bf16* hb; float* ssq; float scale;
    __device__ __forceinline__ void operator()(const f32x4 (&acc)[2][2][4][2], const pg8::Unit& u, int wr, int wc, int fr, int fq) const {
        asm volatile("" : "+v"(fr), "+v"(fq));
#pragma unroll
        for (int ai = 0; ai < 2; ++ai)
#pragma unroll
            for (int m = 0; m < 4; ++m) {
                const int row = u.pm * 256 + ai * 128 + wr * 64 + m * 16 + fr;
                const float* bp = row < NPR ? baseP + (size_t)row * DM : baseS + (size_t)(row - NPR) * DM;
                float ss = 0.f;
#pragma unroll
                for (int bj = 0; bj < 2; ++bj) {
                    const int col = u.pn * 256 + bj * 128 + wc * 32 + fq * 8;
                    f32x4 v0 = *(const f32x4*)(bp + col), v1 = *(const f32x4*)(bp + col + 4);
                    v0 = v0 + acc[ai][bj][m][0] * scale; v1 = v1 + acc[ai][bj][m][1] * scale;
                    *(f32x4*)(h + (size_t)row * DM + col) = v0; *(f32x4*)(h + (size_t)row * DM + col + 4) = v1;
                    ss += (v0.x * v0.x + v0.y * v0.y) + (v0.z * v0.z + v0.w * v0.w) + (v1.x * v1.x + v1.y * v1.y) + (v1.z * v1.z + v1.w * v1.w);
                    if (hb) { v4u w; w.x = cvt_pk_bf16(v0.x, v0.y); w.y = cvt_pk_bf16(v0.z, v0.w); w.z = cvt_pk_bf16(v1.x, v1.y); w.w = cvt_pk_bf16(v1.z, v1.w);
                              *(v4u*)(hb + (size_t)row * DM + col) = w; }
                }
                ss += __shfl_xor(ss, 16); ss += __shfl_xor(ss, 32);
                if (fq == 0) ssq[(size_t)row * 16 + u.pn * 4 + wc] = ss;
            }
    }
};

struct EpiMix {
    static constexpr bool PERM = true, AFTER_DRAIN = false;
    const float* ssq; const float* cosT; const float* sinT; const float* bgate;
    bf16* Q; unsigned short* QI; bf16* KB; bf16* VB; unsigned short* KIB; float* WI; bf16* C; bf16* G; float* out; unsigned char* wsb;
    __device__ __forceinline__ void operator()(const f32x4 (&acc)[2][2][4][2], const pg8::Unit& u, int wr, int wc, int fr, int fq) const {
        asm volatile("" : "+v"(fr), "+v"(fq));
        const int pn = u.pn;
#pragma unroll
        for (int ai = 0; ai < 2; ++ai)
#pragma unroll
            for (int m = 0; m < 4; ++m) {
                const int row = u.pm * 256 + ai * 128 + wr * 64 + m * 16 + fr;
                const float rs = row_rstd16(ssq, row);
                const bool smp = row >= NPR;
                const int sb = (row - NPR) >> 6, sj = (row - NPR) & 63;
                const int pos = smp ? PAST + sj : (row & (TPR - 1));
                const int krow = smp ? NPR + sb * LSM + PAST + sj : row;
                float lo[8], hi[8];
#pragma unroll
                for (int n = 0; n < 2; ++n)
#pragma unroll
                    for (int j = 0; j < 4; ++j) { lo[n * 4 + j] = acc[ai][0][m][n][j] * rs; hi[n * 4 + j] = acc[ai][1][m][n][j] * rs; }
                const bool is_rope = (pn < 4) || (pn == 4 && wc < 2) || (pn == 5 && wc == 0);
                if (is_rope) {
                    const f32x4 c0 = *(const f32x4*)(cosT + pos * 32 + fq * 8), c1 = *(const f32x4*)(cosT + pos * 32 + fq * 8 + 4);
                    const f32x4 s0 = *(const f32x4*)(sinT + pos * 32 + fq * 8), s1 = *(const f32x4*)(sinT + pos * 32 + fq * 8 + 4);
                    const float cs[8] = {c0.x, c0.y, c0.z, c0.w, c1.x, c1.y, c1.z, c1.w}, sn[8] = {s0.x, s0.y, s0.z, s0.w, s1.x, s1.y, s1.z, s1.w};
#pragma unroll
                    for (int i = 0; i < 8; ++i) { const float a = lo[i], b = hi[i]; lo[i] = a * cs[i] - b * sn[i]; hi[i] = b * cs[i] + a * sn[i]; }
                    if (pn < 2) {
                        bf16* p = Q + (size_t)row * 512 + (4 * pn + wc) * 64 + fq * 8;
                        v4u w; w.x = cvt_pk_bf16(lo[0], lo[1]); w.y = cvt_pk_bf16(lo[2], lo[3]); w.z = cvt_pk_bf16(lo[4], lo[5]); w.w = cvt_pk_bf16(lo[6], lo[7]); *(v4u*)p = w;
                        w.x = cvt_pk_bf16(hi[0], hi[1]); w.y = cvt_pk_bf16(hi[2], hi[3]); w.z = cvt_pk_bf16(hi[4], hi[5]); w.w = cvt_pk_bf16(hi[6], hi[7]); *(v4u*)(p + 32) = w;
                    } else if (pn < 4) {
                        unsigned short* p = QI + (size_t)row * 512 + (4 * (pn - 2) + wc) * 64 + fq * 8;
                        v4u w; w.x = pkh(lo[0], lo[1]); w.y = pkh(lo[2], lo[3]); w.z = pkh(lo[4], lo[5]); w.w = pkh(lo[6], lo[7]); *(v4u*)p = w;
                        w.x = pkh(hi[0], hi[1]); w.y = pkh(hi[2], hi[3]); w.z = pkh(hi[4], hi[5]); w.w = pkh(hi[6], hi[7]); *(v4u*)(p + 32) = w;
                    } else if (pn == 4) {
                        float* o = out + (smp ? O_KS + (size_t)(row - NPR) * 128 : O_KP + (size_t)row * 128) + wc * 64 + fq * 8;
                        *(f32x4*)o = (f32x4){lo[0], lo[1], lo[2], lo[3]}; *(f32x4*)(o + 4) = (f32x4){lo[4], lo[5], lo[6], lo[7]};
                        *(f32x4*)(o + 32) = (f32x4){hi[0], hi[1], hi[2], hi[3]}; *(f32x4*)(o + 36) = (f32x4){hi[4], hi[5], hi[6], hi[7]};
                        bf16* p = KB + (size_t)krow * 128 + wc * 64 + fq * 8;
                        v4u w; w.x = cvt_pk_bf16(lo[0], lo[1]); w.y = cvt_pk_bf16(lo[2], lo[3]); w.z = cvt_pk_bf16(lo[4], lo[5]); w.w = cvt_pk_bf16(lo[6], lo[7]); *(v4u*)p = w;
                        w.x = cvt_pk_bf16(hi[0], hi[1]); w.y = cvt_pk_bf16(hi[2], hi[3]); w.z = cvt_pk_bf16(hi[4], hi[5]); w.w = cvt_pk_bf16(hi[6], hi[7]); *(v4u*)(p + 32) = w;
                    } else {
                        float* o = out + (smp ? O_IS + (size_t)(row - NPR) * 64 : O_IP + (size_t)row * 64) + fq * 8;
                        *(f32x4*)o = (f32x4){lo[0], lo[1], lo[2], lo[3]}; *(f32x4*)(o + 4) = (f32x4){lo[4], lo[5], lo[6], lo[7]};
                        *(f32x4*)(o + 32) = (f32x4){hi[0], hi[1], hi[2], hi[3]}; *(f32x4*)(o + 36) = (f32x4){hi[4], hi[5], hi[6], hi[7]};
                        unsigned short* p = KIB + (size_t)krow * 64 + fq * 8;
                        v4u w; w.x = pkh(lo[0], lo[1]); w.y = pkh(lo[2], lo[3]); w.z = pkh(lo[4], lo[5]); w.w = pkh(lo[6], lo[7]); *(v4u*)p = w;
                        w.x = pkh(hi[0], hi[1]); w.y = pkh(hi[2], hi[3]); w.z = pkh(hi[4], hi[5]); w.w = pkh(hi[6], hi[7]); *(v4u*)(p + 32) = w;
                    }
                } else if (pn == 4) {
                    const int vc = (wc - 2) * 32 + fq * 8;
                    float* o = out + (smp ? O_VS + (size_t)(row - NPR) * 128 : O_VP + (size_t)row * 128) + vc;
                    *(f32x4*)o = (f32x4){lo[0], lo[1], lo[2], lo[3]}; *(f32x4*)(o + 4) = (f32x4){lo[4], lo[5], lo[6], lo[7]};
                    *(f32x4*)(o + 64) = (f32x4){hi[0], hi[1], hi[2], hi[3]}; *(f32x4*)(o + 68) = (f32x4){hi[4], hi[5], hi[6], hi[7]};
                    bf16* p = VB + (size_t)krow * 128 + vc;
                    v4u w; w.x = cvt_pk_bf16(lo[0], lo[1]); w.y = cvt_pk_bf16(lo[2], lo[3]); w.z = cvt_pk_bf16(lo[4], lo[5]); w.w = cvt_pk_bf16(lo[6], lo[7]); *(v4u*)p = w;
                    w.x = cvt_pk_bf16(hi[0], hi[1]); w.y = cvt_pk_bf16(hi[2], hi[3]); w.z = cvt_pk_bf16(hi[4], hi[5]); w.w = cvt_pk_bf16(hi[6], hi[7]); *(v4u*)(p + 64) = w;
                } else if (pn == 5) {
                    if (wc == 1 && fq == 0) {
                        const float sc = 0.35355339059327373f;
                        float* o = WI + (size_t)row * 8;
                        *(f32x4*)o = (f32x4){lo[0] * sc, lo[1] * sc, lo[2] * sc, lo[3] * sc}; *(f32x4*)(o + 4) = (f32x4){lo[4] * sc, lo[5] * sc, lo[6] * sc, lo[7] * sc};
                    }
                } else if (pn < 10) {
                    const int ch = (pn - 6) * 128 + wc * 32 + fq * 8;
                    float cv[8];
#pragma unroll
                    for (int i = 0; i < 8; ++i) cv[i] = lo[i] * sigmoidf_(hi[i]);
                    v4u w; w.x = cvt_pk_bf16(cv[0], cv[1]); w.y = cvt_pk_bf16(cv[2], cv[3]); w.z = cvt_pk_bf16(cv[4], cv[5]); w.w = cvt_pk_bf16(cv[6], cv[7]);
                    *(v4u*)(C + (size_t)row * 512 + ch) = w;
                    if (!smp && (row & 255) >= 226 && ((row >> 8) & 31) != 31) { const int p = row >> 8;
                        *(v4u*)((bf16*)(wsb + ((p >> 5) ? WS_HALO_B : WS_HALO_A)) + (size_t)((p & 31) * 30 + (row & 255) - 226) * 512 + ch) = w; }
                    int crow = -1; size_t cb = 0;
                    if (smp) { if (sj >= 34) { crow = sb * 30 + sj - 34; cb = O_CS; } }
                    else { const int b = row >> 13; if (pos >= TPR - 30) { crow = b * 30 + pos - (TPR - 30); cb = O_CP; } }
                    if (crow >= 0) { float* o = out + cb + (size_t)crow * 512 + ch;
                        *(f32x4*)o = (f32x4){cv[0], cv[1], cv[2], cv[3]}; *(f32x4*)(o + 4) = (f32x4){cv[4], cv[5], cv[6], cv[7]}; }
                } else {
                    const int col = (pn - 10) * 256 + wc * 32 + fq * 8;
                    const f32x4 b0 = *(const f32x4*)(bgate + col), b1 = *(const f32x4*)(bgate + col + 4), b2 = *(const f32x4*)(bgate + col + 128), b3 = *(const f32x4*)(bgate + col + 132);
                    v4u w; w.x = cvt_pk_bf16(sigmoidf_(lo[0] + b0.x), sigmoidf_(lo[1] + b0.y)); w.y = cvt_pk_bf16(sigmoidf_(lo[2] + b0.z), sigmoidf_(lo[3] + b0.w));
                    w.z = cvt_pk_bf16(sigmoidf_(lo[4] + b1.x), sigmoidf_(lo[5] + b1.y)); w.w = cvt_pk_bf16(sigmoidf_(lo[6] + b1.z), sigmoidf_(lo[7] + b1.w));
                    *(v4u*)(G + (size_t)row * 2048 + col) = w;
                    w.x = cvt_pk_bf16(sigmoidf_(hi[0] + b2.x), sigmoidf_(hi[1] + b2.y)); w.y = cvt_pk_bf16(sigmoidf_(hi[2] + b2.z), sigmoidf_(hi[3] + b2.w));
                    w.z = cvt_pk_bf16(sigmoidf_(hi[4] + b3.x), sigmoidf_(hi[5] + b3.y)); w.w = cvt_pk_bf16(sigmoidf_(hi[6] + b3.z), sigmoidf_(hi[7] + b3.w));
                    *(v4u*)(G + (size_t)row * 2048 + col + 128) = w;
                }
                asm volatile("" ::: "memory");
            }
    }
};

struct EpiMerge {
    static constexpr bool PERM = true, AFTER_DRAIN = false;
    const bf16* G; bf16* MG;
    __device__ __forceinline__ void operator()(const f32x4 (&acc)[2][2][4][2], const pg8::Unit& u, int wr, int wc, int fr, int fq) const {
        asm volatile("" : "+v"(fr), "+v"(fq));
#pragma unroll
        for (int ai = 0; ai < 2; ++ai)
#pragma unroll
            for (int m = 0; m < 4; ++m) {
                const int row = u.pm * 256 + ai * 128 + wr * 64 + m * 16 + fr;
#pragma unroll
                for (int bj = 0; bj < 2; ++bj) {
                    const int col = u.pn * 256 + bj * 128 + wc * 32 + fq * 8;
                    const v4u g = *(const v4u*)(G + (size_t)row * 2048 + (u.z ? 1024 : 0) + col);
                    float o[8];
                    o[0] = bflo(g.x) * acc[ai][bj][m][0].x; o[1] = bfhi(g.x) * acc[ai][bj][m][0].y; o[2] = bflo(g.y) * acc[ai][bj][m][0].z; o[3] = bfhi(g.y) * acc[ai][bj][m][0].w;
                    o[4] = bflo(g.z) * acc[ai][bj][m][1].x; o[5] = bfhi(g.z) * acc[ai][bj][m][1].y; o[6] = bflo(g.w) * acc[ai][bj][m][1].z; o[7] = bfhi(g.w) * acc[ai][bj][m][1].w;
                    bf16* p = MG + (size_t)row * DM + col;
                    if (u.z) { const v4u t = *(const v4u*)p;
                        o[0] += bflo(t.x); o[1] += bfhi(t.x); o[2] += bflo(t.y); o[3] += bfhi(t.y); o[4] += bflo(t.z); o[5] += bfhi(t.z); o[6] += bflo(t.w); o[7] += bfhi(t.w); }
                    v4u w; w.x = cvt_pk_bf16(o[0], o[1]); w.y = cvt_pk_bf16(o[2], o[3]); w.z = cvt_pk_bf16(o[4], o[5]); w.w = cvt_pk_bf16(o[6], o[7]);
                    *(v4u*)p = w;
                }
            }
    }
};

__device__ __forceinline__ void p0_transpose_item(const float* W, int K, int N, bf16* WT, int src0, int nvalid, int dst0, const float* gain, int kb, LAS float* scr, int lane) {
    const int k0 = 64 * kb;
#pragma unroll 8
    for (int i = 0; i < 32; ++i) { const int kk = 2 * i + (lane >> 5), nn = lane & 31;
        float v = (nn < nvalid) ? W[(size_t)(k0 + kk) * N + src0 + nn] : 0.f; if (gain) v *= gain[k0 + kk]; scr[kk * 33 + nn] = v; }
    LDS_WAIT(); asm volatile("" ::: "memory");
    const int c = lane & 7;
#pragma unroll
    for (int j = 0; j < 4; ++j) { const int n = (lane >> 3) + 8 * j; const LAS float* s = scr + (8 * c) * 33 + n;
        v4u o; o.x = pk2(s[0 * 33], s[1 * 33]); o.y = pk2(s[2 * 33], s[3 * 33]); o.z = pk2(s[4 * 33], s[5 * 33]); o.w = pk2(s[6 * 33], s[7 * 33]);
        *(v4u*)(WT + (size_t)(dst0 + n) * K + k0 + 8 * c) = o; }
    LDS_WAIT(); asm volatile("" ::: "memory");
}
__device__ __forceinline__ int map_swiglu(int R) { const int pn = R >> 8, r = R & 255; return r < 128 ? 128 * pn + r : DFF + 128 * pn + (r - 128); }
__device__ __forceinline__ void map_win(int R, int& src, int& nv) {
    const int t = R >> 8, r = R & 255; nv = 32;
    if (t < 4) { const int base = t < 2 ? 0 : 768, tt = t & 1; src = r < 128 ? base + (4 * tt + (r >> 5)) * 64 : base + (4 * tt + ((r - 128) >> 5)) * 64 + 32; }
    else if (t == 4) { if (r < 64) src = 512 + (r >> 5) * 64; else if (r < 128) src = 640 + (r - 64); else if (r < 192) src = 512 + ((r - 128) >> 5) * 64 + 32; else src = 704 + (r - 192); }
    else if (t == 5) { if (r == 0) src = 1280; else if (r == 32) { src = 1344; nv = 8; } else if (r == 128) src = 1312; else { src = 0; nv = 0; } }
    else if (t < 10) { const int tt = t - 6; src = r < 128 ? 1352 + 128 * tt + r : 1864 + 128 * tt + (r - 128); }
    else src = 2376 + 256 * (t - 10) + r;
}
__device__ __forceinline__ void sincos_tab(double a, float& c, float& s) {
    const double k = rint(a * 0.63661977236758134308);
    double r = fma(-k, 1.57079632679489655800e+00, a); r = fma(-k, 6.12323399573676603587e-17, r);
    const int q = (int)k & 3; const double r2 = r * r;
    double sp = 1.0 / 6227020800.0; sp = sp * r2 - 1.0 / 39916800.0; sp = sp * r2 + 1.0 / 362880.0; sp = sp * r2 - 1.0 / 5040.0; sp = sp * r2 + 1.0 / 120.0; sp = sp * r2 - 1.0 / 6.0; sp = sp * r2 + 1.0; sp = sp * r;
    double cp = -1.0 / 87178291200.0; cp = cp * r2 + 1.0 / 479001600.0; cp = cp * r2 - 1.0 / 3628800.0; cp = cp * r2 + 1.0 / 40320.0; cp = cp * r2 - 1.0 / 720.0; cp = cp * r2 + 1.0 / 24.0; cp = cp * r2 - 0.5; cp = cp * r2 + 1.0;
    const double cc = (q == 0) ? cp : (q == 1) ? -sp : (q == 2) ? -cp : sp;
    const double ss = (q == 0) ? sp : (q == 1) ? cp : (q == 2) ? -sp : -cp;
    c = (float)cc; s = (float)ss;
}

__device__ __forceinline__ float topk_rebuild(LAS float* val, LAS unsigned short* idx, LAS unsigned* hist, int c, int lane) {
    unsigned hi[16], lo[16]; unsigned alive = 0u, sel = 0u;
#pragma unroll
    for (int k = 0; k < 16; ++k) { const int e = lane + 64 * k; hi[k] = 0u; lo[k] = 0u;
        if (e < c) { unsigned uu = __float_as_uint(val[e]); uu = (uu & 0x80000000u) ? ~uu : (uu | 0x80000000u); hi[k] = uu; lo[k] = 0xFFFFu - (unsigned)idx[e]; alive |= 1u << k; } }
    unsigned need = 256u;
#pragma unroll 1
    for (int p = 0; p < 6; ++p) {
        const int sh = p < 4 ? 24 - 8 * p : 8 * (5 - p);
        ((LAS v4u*)hist)[lane] = (v4u){0u, 0u, 0u, 0u};
#pragma unroll
        for (int k = 0; k < 16; ++k) if ((alive >> k) & 1u) { const unsigned d = ((p < 4 ? hi[k] : lo[k]) >> sh) & 255u; atomicAdd((unsigned*)(hist + d), 1u); }
        const v4u h4 = ((LAS v4u*)hist)[lane];
        const unsigned tot = h4.x + h4.y + h4.z + h4.w; unsigned incl = tot;
#pragma unroll
        for (int o = 1; o < 64; o <<= 1) { const unsigned t = __shfl_down(incl, o); if (lane + o < 64) incl += t; }
        const unsigned a3 = incl - tot, a2 = a3 + h4.w, a1 = a2 + h4.z, a0 = a1 + h4.y;
        int fi = -1; unsigned fa = 0u, fh = 0u;
        if (a3 < need && need <= a3 + h4.w) { fi = 3; fa = a3; fh = h4.w; }
        else if (a2 < need && need <= a2 + h4.z) { fi = 2; fa = a2; fh = h4.z; }
        else if (a1 < need && need <= a1 + h4.y) { fi = 1; fa = a1; fh = h4.y; }
        else if (a0 < need && need <= a0 + h4.x) { fi = 0; fa = a0; fh = h4.x; }
        const unsigned long long mk = __ballot(fi >= 0);
        const int src = mk ? (__ffsll((long long)mk) - 1) : 0;
        const unsigned bstar = (unsigned)__shfl(4 * lane + fi, src); fa = (unsigned)__shfl((int)fa, src); fh = (unsigned)__shfl((int)fh, src);
        need -= fa;
#pragma unroll
        for (int k = 0; k < 16; ++k) if ((alive >> k) & 1u) { const unsigned d = ((p < 4 ? hi[k] : lo[k]) >> sh) & 255u; if (d > bstar) sel |= 1u << k; if (d != bstar) alive &= ~(1u << k); }
        if (fh == need) break;
    }
    sel |= alive;
    unsigned mn = 0xFFFFFFFFu;
#pragma unroll
    for (int k = 0; k < 16; ++k) if ((sel >> k) & 1u) mn = hi[k] < mn ? hi[k] : mn;
#pragma unroll
    for (int o = 1; o < 64; o <<= 1) { const unsigned t = (unsigned)__shfl_xor((int)mn, o); mn = t < mn ? t : mn; }
    int base = 0;
#pragma unroll
    for (int k = 0; k < 16; ++k) { const bool b = (sel >> k) & 1u; const unsigned long long bm = __ballot(b);
        if (b) { const int pos = base + __popcll(bm & ((1ull << lane) - 1ull)); const unsigned uu = hi[k];
            val[pos] = __uint_as_float((uu & 0x80000000u) ? (uu & 0x7FFFFFFFu) : ~uu); idx[pos] = (unsigned short)(0xFFFFu - lo[k]); }
        base += __popcll(bm); }
    return __uint_as_float((mn & 0x80000000u) ? (mn & 0x7FFFFFFFu) : ~mn);
}

__device__ __forceinline__ void attn_query(int tok, int nsel, int keybase, const LAS unsigned short* sidx, LAS float* P, LAS float* INV,
                                           const bf16* Qp, const bf16* KBp, const bf16* VBp, bf16* AOp, int lane) {
    const int q16 = lane & 15, g4 = lane >> 4;
    bf16x8 Bq[2][2];
#pragma unroll
    for (int c = 0; c < 2; ++c)
#pragma unroll
        for (int ks = 0; ks < 2; ++ks) {
            bf16x8 z = {0, 0, 0, 0, 0, 0, 0, 0};
            if (q16 < 8 && (q16 >> 2) == c) z = *(const bf16x8*)(Qp + (size_t)tok * 512 + q16 * 64 + ks * 32 + g4 * 8);
            Bq[c][ks] = z;
        }
    float mx = -INFINITY;
#pragma unroll 2
    for (int t = 0; t < 16; ++t) {
        const int slot = 16 * t + q16; const int kidx = slot < nsel ? (int)sidx[slot] : 0;
        const bf16* kp = KBp + (size_t)(keybase + kidx) * 128 + g4 * 8;
        const bf16x8 a00 = *(const bf16x8*)kp, a01 = *(const bf16x8*)(kp + 32), a10 = *(const bf16x8*)(kp + 64), a11 = *(const bf16x8*)(kp + 96);
        f32x4 acc = {0.f, 0.f, 0.f, 0.f};
        acc = __builtin_amdgcn_mfma_f32_16x16x32_bf16(a00, Bq[0][0], acc, 0, 0, 0);
        acc = __builtin_amdgcn_mfma_f32_16x16x32_bf16(a01, Bq[0][1], acc, 0, 0, 0);
        acc = __builtin_amdgcn_mfma_f32_16x16x32_bf16(a10, Bq[1][0], acc, 0, 0, 0);
        acc = __builtin_amdgcn_mfma_f32_16x16x32_bf16(a11, Bq[1][1], acc, 0, 0, 0);
#pragma unroll
        for (int j = 0; j < 4; ++j) { const int sl = 16 * t + 4 * g4 + j; const float v = sl < nsel ? acc[j] * 0.125f : -INFINITY; mx = fmaxf(mx, v); if (q16 < 8) P[sl * 8 + q16] = v; }
    }
    mx = fmaxf(mx, __shfl_xor(mx, 16)); mx = fmaxf(mx, __shfl_xor(mx, 32));
    LDS_WAIT(); asm volatile("" ::: "memory");
    float sum = 0.f;
    if (q16 < 8) {
#pragma unroll 4
        for (int t = 0; t < 16; ++t)
#pragma unroll
            for (int j = 0; j < 4; ++j) { const int sl = 16 * t + 4 * g4 + j; const float e = __expf(P[sl * 8 + q16] - mx); P[sl * 8 + q16] = e; sum += e; }
    }
    sum += __shfl_xor(sum, 16); sum += __shfl_xor(sum, 32);
    if (lane < 8) INV[lane] = 1.0f / sum;
    LDS_WAIT(); asm volatile("" ::: "memory");
    const int c = lane >> 5, dp = lane & 31;
    float o[4][2];
#pragma unroll
    for (int h = 0; h < 4; ++h) { o[h][0] = 0.f; o[h][1] = 0.f; }
    const bf16* vbase = VBp + (size_t)keybase * 128 + c * 64 + 2 * dp;
#pragma unroll 1
    for (int s = 0; s < 256; s += 4) {
        const v2u i4 = *(const LAS v2u*)(sidx + s);
        int k0 = i4.x & 0xffff, k1 = i4.x >> 16, k2 = i4.y & 0xffff, k3 = i4.y >> 16;
        if (s >= nsel) { k0 = 0; k1 = 0; k2 = 0; k3 = 0; }
        const unsigned v0 = *(const unsigned*)(vbase + (size_t)k0 * 128), v1 = *(const unsigned*)(vbase + (size_t)k1 * 128),
                       v2 = *(const unsigned*)(vbase + (size_t)k2 * 128), v3 = *(const unsigned*)(vbase + (size_t)k3 * 128);
        const f32x4 p0 = *(const LAS f32x4*)(P + (s + 0) * 8 + 4 * c), p1 = *(const LAS f32x4*)(P + (s + 1) * 8 + 4 * c),
                    p2 = *(const LAS f32x4*)(P + (s + 2) * 8 + 4 * c), p3 = *(const LAS f32x4*)(P + (s + 3) * 8 + 4 * c);
#pragma unroll
        for (int h = 0; h < 4; ++h) {
            o[h][0] += p0[h] * bflo(v0); o[h][1] += p0[h] * bfhi(v0);
            o[h][0] += p1[h] * bflo(v1); o[h][1] += p1[h] * bfhi(v1);
            o[h][0] += p2[h] * bflo(v2); o[h][1] += p2[h] * bfhi(v2);
            o[h][0] += p3[h] * bflo(v3); o[h][1] += p3[h] * bfhi(v3);
        }
    }
    const f32x4 iv = *(const LAS f32x4*)(INV + 4 * c);
#pragma unroll
    for (int h = 0; h < 4; ++h) *(unsigned*)(AOp + (size_t)tok * 512 + (4 * c + h) * 64 + 2 * dp) = cvt_pk_bf16(o[h][0] * iv[h], o[h][1] * iv[h]);
    LDS_WAIT(); asm volatile("" ::: "memory");
}

#define GSYNC() do { __builtin_amdgcn_fence(__ATOMIC_RELEASE, "agent"); asm volatile("s_waitcnt vmcnt(0)" ::: "memory"); grid.sync(); __builtin_amdgcn_fence(__ATOMIC_ACQUIRE, "agent"); asm volatile("s_waitcnt vmcnt(0)" ::: "memory"); __syncthreads(); } while (0)
#ifndef PHMASK
#define PHMASK 0x3ff
#endif
__global__ void __launch_bounds__(512, 2) mega_fwd(Args args) {
    extern __shared__ __attribute__((aligned(16))) unsigned char lds_raw[];
    cg::grid_group grid = cg::this_grid();
    LAS unsigned char* lds = (LAS unsigned char*)lds_raw;
    const int tid = threadIdx.x, lane = tid & 63, wave = __builtin_amdgcn_readfirstlane(tid >> 6);
    const int G = gridDim.x, bx = blockIdx.x;
    const int gw = bx * NWAVES + wave, NGW = G * NWAVES;
    volatile LAS int* XW = (volatile LAS int*)(lds + 131072 + 64);
    const unsigned xcc = (unsigned)__builtin_amdgcn_s_getreg((3 << 11) | 20) & 0xFu;
    if (tid == 0) XW[0] = (int)__hip_atomic_fetch_add((unsigned*)(args.ws + WS_CTL) + 1024 + 64 * xcc, 1u, __ATOMIC_RELAXED, __HIP_MEMORY_SCOPE_AGENT);
#define ws (args.ws)
#define out (args.out)
#define xP (args.in[0])
#define xS (args.in[1])
#define W1T ((bf16*)(ws + WS_W1T))
#define W1OT ((bf16*)(ws + WS_W1OT))
#define WINT ((bf16*)(ws + WS_WINT))
#define WCOT ((bf16*)(ws + WS_WCOT))
#define WAOT ((bf16*)(ws + WS_WAOT))
#define WOT ((bf16*)(ws + WS_WOT))
#define W2T ((bf16*)(ws + WS_W2T))
#define W2OT ((bf16*)(ws + WS_W2OT))
#define XB ((bf16*)(ws + WS_XB))
#define ACT ((bf16*)(ws + WS_ACT))
#define GATE ((bf16*)(ws + WS_GATE))
#define CB ((bf16*)(ws + WS_C))
#define QB ((bf16*)(ws + WS_Q))
#define QIB ((unsigned short*)(ws + WS_QI))
#define MG ((bf16*)(ws + WS_MERGED))
#define KB ((bf16*)(ws + WS_KB))
#define VB ((bf16*)(ws + WS_VB))
#define KIB ((unsigned short*)(ws + WS_KIB))
#define AO ((bf16*)(ws + WS_AO))
#define CA ((bf16*)(ws + WS_CA))
#define RSTD0 ((float*)(ws + WS_RSTD0))
#define WI ((float*)(ws + WS_WI))
#define SSQ1 ((float*)(ws + WS_SSQ1))
#define SSQ2 ((float*)(ws + WS_SSQ2))
#define SSQ3 ((float*)(ws + WS_SSQ3))
#define COST ((float*)(ws + WS_COS))
#define SINT ((float*)(ws + WS_SIN))
#define CTL ((unsigned*)(ws + WS_CTL))
#define H (out + O_Y)

    if (PHMASK & (1 << 0)) {
        LAS float* scr = (LAS float*)(lds + wave * 16384);
        if (bx == 0 && tid < 16) { CTL[2048 + 64 * tid] = 0u; CTL[3072 + 64 * tid] = 0u; }
        constexpr int I_W1 = 16 * 176, I_W1O = 44 * 32, I_WIN = 16 * 144, I_WCO = 8 * 32, I_WAO = 8 * 32, I_WO = 16 * 32, I_W2 = I_W1, I_W2O = I_W1O;
        constexpr int NIT = I_W1 + I_W1O + I_WIN + I_WCO + I_WAO + I_WO + I_W2 + I_W2O;
        for (int it = gw; it < NIT; it += NGW) {
            int r = it;
            if (r < I_W1) { const int kb = r / 176, g = r % 176; p0_transpose_item(args.in[7], 1024, 2 * DFF, W1T, map_swiglu(32 * g), 32, 32 * g, args.in[6], kb, scr, lane); continue; } r -= I_W1;
            if (r < I_W1O) { const int kb = r / 32, g = r % 32; p0_transpose_item(args.in[8], DFF, 1024, W1OT, 32 * g, 32, 32 * g, nullptr, kb, scr, lane); continue; } r -= I_W1O;
            if (r < I_WIN) { const int kb = r / 144, g = r % 144; int src, nv; map_win(32 * g, src, nv); p0_transpose_item(args.in[10], 1024, 4424, WINT, src, nv, 32 * g, args.in[9], kb, scr, lane); continue; } r -= I_WIN;
            if (r < I_WCO) { const int kb = r / 32, g = r % 32; p0_transpose_item(args.in[16], 512, 1024, WCOT, 32 * g, 32, 32 * g, nullptr, kb, scr, lane); continue; } r -= I_WCO;
            if (r < I_WAO) { const int kb = r / 32, g = r % 32; p0_transpose_item(args.in[17], 512, 1024, WAOT, 32 * g, 32, 32 * g, nullptr, kb, scr, lane); continue; } r -= I_WAO;
            if (r < I_WO) { const int kb = r / 32, g = r % 32; p0_transpose_item(args.in[18], 1024, 1024, WOT, 32 * g, 32, 32 * g, nullptr, kb, scr, lane); continue; } r -= I_WO;
            if (r < I_W2) { const int kb = r / 176, g = r % 176; p0_transpose_item(args.in[20], 1024, 2 * DFF, W2T, map_swiglu(32 * g), 32, 32 * g, args.in[19], kb, scr, lane); continue; } r -= I_W2;
            { const int kb = r / 32, g = r % 32; p0_transpose_item(args.in[21], DFF, 1024, W2OT, 32 * g, 32, 32 * g, nullptr, kb, scr, lane); }
        }
        for (int row = gw; row < NTOK; row += NGW) {
            const float* xr = row < NPR ? xP + (size_t)row * DM : xS + (size_t)(row - NPR) * DM;
            f32x4 v[4]; float ss = 0.f;
#pragma unroll
            for (int j = 0; j < 4; ++j) { v[j] = *(const f32x4*)(xr + 4 * lane + 256 * j); ss += (v[j].x * v[j].x + v[j].y * v[j].y) + (v[j].z * v[j].z + v[j].w * v[j].w); }
            ss = wave_sum(ss);
            if (lane == 0) RSTD0[row] = 1.0f / sqrtf(ss * (1.0f / 1024.0f) + EPS);
#pragma unroll
            for (int j = 0; j < 4; ++j) { v2u w; w.x = pk2(v[j].x, v[j].y); w.y = pk2(v[j].z, v[j].w); *(v2u*)(XB + (size_t)row * DM + 4 * lane + 256 * j) = w; }
        }
        for (int ch = gw; ch < 40960; ch += NGW) {
            if (ch < 32768) { const bool isv = ch >= 16384; const int e = (isv ? ch - 16384 : ch) * 256 + 4 * lane; const int b = e >> 17, rem = e & 131071;
                const f32x4 v = *(const f32x4*)((isv ? args.in[3] : args.in[2]) + e);
                v2u w; w.x = pk2(v.x, v.y); w.y = pk2(v.z, v.w); *(v2u*)((isv ? VB : KB) + (size_t)(NPR + b * LSM) * 128 + rem) = w; }
            else { const int e = (ch - 32768) * 256 + 4 * lane; const int b = e >> 16, rem = e & 65535;
                const f32x4 v = *(const f32x4*)(args.in[4] + e);
                v2u w; w.x = pkh(v.x, v.y); w.y = pkh(v.z, v.w); *(v2u*)(KIB + (size_t)(NPR + b * LSM) * 64 + rem) = w; }
        }
        for (int e = bx * 512 + tid; e < TPR * 32; e += G * 512) { float c, s; sincos_tab((double)(e >> 5) * args.invf[e & 31], c, s); COST[e] = c; SINT[e] = s; }
    }
    GSYNC();
    if (tid == 0) {
        int nx = 0, xi = 0, nloc = 1;
        for (int j = 0; j < 16; ++j) { const int c = (int)__hip_atomic_load(CTL + 1024 + 64 * j, __ATOMIC_RELAXED, __HIP_MEMORY_SCOPE_AGENT);
            if (c > 0) { if (j == (int)xcc) { xi = nx; nloc = c; } ++nx; } }
        XW[1] = nx > 0 ? nx : 1; XW[2] = xi; XW[3] = nloc;
    }
    __syncthreads();
    const int x_r = __builtin_amdgcn_readfirstlane(XW[0]), x_nx = __builtin_amdgcn_readfirstlane(XW[1]), x_xi = __builtin_amdgcn_readfirstlane(XW[2]), x_nloc = __builtin_amdgcn_readfirstlane(XW[3]);
    const int x_T = (72 - x_xi + x_nx - 1) / x_nx;

    if (PHMASK & (1 << 1)) {
        pg8::Gemm g{XB, W1T, XB, W1T, NTOK, 2 * DFF, 1024}; pg8::XcdOrder S; S.init(NTOK, 2 * DFF, x_xi, x_nx, x_nloc, x_r, 0);
        EpiSwiglu E{ACT, RSTD0, nullptr};
        pg8::gemm_phase<EpiSwiglu, pg8::XcdOrder, true, true>(lds, g, S, E);
    }
    GSYNC();
    if (PHMASK & (1 << 2)) {
        pg8::Gemm g{ACT, W1OT, ACT, W1OT, NTOK, 1024, DFF}; pg8::XcdOrder S; S.init(NTOK, 1024, x_xi, x_nx, x_nloc, x_r, 0);
        EpiResid E{xP, xS, H, XB, SSQ1, 0.5f};
        pg8::gemm_phase<EpiResid, pg8::XcdOrder, true, true>(lds, g, S, E);
    }
    GSYNC();
    if (PHMASK & (1 << 3)) {
        pg8::Gemm g{XB, WINT, XB, WINT, NTOK, NIN, 1024}; pg8::XcdOrder S; S.init(NTOK, NIN, x_xi, x_nx, x_nloc, x_r, 0);
        EpiMix E{SSQ1, COST, SINT, args.in[11], QB, QIB, KB, VB, KIB, WI, CB, GATE, out, ws};
        pg8::gemm_phase<EpiMix, pg8::XcdOrder, true, true>(lds, g, S, E);
    }
    GSYNC();
    if (PHMASK & (1 << 4)) {
        LAS float* cval = (LAS float*)(lds + L_VAL); LAS unsigned short* cidx = (LAS unsigned short*)(lds + L_IDX);
        LAS unsigned* hist = (LAS unsigned*)(lds + L_HIST) + wave * 256;
        volatile LAS unsigned* cnt = (volatile LAS unsigned*)(lds + L_CNT); volatile LAS float* tau = (volatile LAS float*)(lds + L_TAU);
        volatile LAS int* itemw = (volatile LAS int*)(lds + L_ITEM);
        const int q16 = lane & 15, g4 = lane >> 4;
        const int N_ATT = x_T * 16, N_CONV = x_T * 4;
        if (tid == 0) {
            for (int t = 0; t < 16; ++t) { XW[16 + t] = 0; XW[32 + t] = -1; }
            for (int t = 0; t < x_T && t < 16; ++t) { const int pm = x_xi + x_nx * t; XW[16 + t] = pm; XW[32 + t] = pm < 64 ? 8 * (pm & 31) + 7 : 33; }
            for (int a = 0; a < 16; ++a) { int best = a; for (int b2 = a + 1; b2 < 16; ++b2) if (XW[32 + b2] > XW[32 + best]) best = b2;
                const int tk = XW[32 + a], tt = XW[16 + a]; XW[32 + a] = XW[32 + best]; XW[16 + a] = XW[16 + best]; XW[32 + best] = tk; XW[16 + best] = tt; }
        }
        for (;;) {
            __syncthreads();
            if (tid == 0) *itemw = (int)atomicAdd(CTL + 2048 + 64 * x_xi, 1u);
            __syncthreads();
            const int item = *itemw;
            if (item >= N_ATT) break;
            {
                int tok0, N, keybase;
                { const int tile = XW[16 + (item >> 4)], sub = item & 15;
                  if (tile < 64) { const int b = tile >> 5, cl = 3 - (sub >> 2), c = (tile & 31) * 4 + cl, qq = sub & 3; tok0 = tile * 256 + cl * 64 + qq * 16; N = 64 * (c + 1); keybase = b * TPR; }
                  else { tok0 = tile * 256 + sub * 16; const int b = (tok0 - NPR) >> 6; N = LSM; keybase = NPR + b * LSM; } }
                if (N > 256) {
                    if (tid < 16) { cnt[tid] = 0u; tau[tid] = -INFINITY; }
                    h16x8 Bq[8][2];
#pragma unroll
                    for (int h = 0; h < 8; ++h)
#pragma unroll
                        for (int ks = 0; ks < 2; ++ks) Bq[h][ks] = *(const h16x8*)(QIB + (size_t)(tok0 + q16) * 512 + h * 64 + ks * 32 + g4 * 8);
                    const f32x4 w0 = *(const f32x4*)(WI + (size_t)(tok0 + q16) * 8), w1 = *(const f32x4*)(WI + (size_t)(tok0 + q16) * 8 + 4);
                    const float wq[8] = {w0.x, w0.y, w0.z, w0.w, w1.x, w1.y, w1.z, w1.w};
                    __syncthreads();
                    const int nrounds = (N + 511) >> 9;
                    for (int r = 0; r < nrounds; ++r) {
                        const int seg = r * 512 + wave * 64;
                        const float tq = tau[q16];
                        if (seg < N) {
#pragma unroll 1
                            for (int t = 0; t < 4; ++t) {
                                const int key0 = seg + 16 * t;
                                const unsigned short* kp = KIB + (size_t)(keybase + key0 + q16) * 64 + g4 * 8;
                                const h16x8 a0 = *(const h16x8*)kp, a1 = *(const h16x8*)(kp + 32);
                                f32x4 sc = {0.f, 0.f, 0.f, 0.f};
#pragma unroll
                                for (int h = 0; h < 8; ++h) {
                                    f32x4 acc = {0.f, 0.f, 0.f, 0.f};
                                    acc = __builtin_amdgcn_mfma_f32_16x16x32_f16(a0, Bq[h][0], acc, 0, 0, 0);
                                    acc = __builtin_amdgcn_mfma_f32_16x16x32_f16(a1, Bq[h][1], acc, 0, 0, 0);
#pragma unroll
                                    for (int j = 0; j < 4; ++j) sc[j] += wq[h] * fmaxf(acc[j], 0.f);
                                }
#pragma unroll
                                for (int j = 0; j < 4; ++j) if (sc[j] > tq) {
                                    const unsigned pos = atomicAdd((unsigned*)(cnt + q16), 1u);
                                    cval[q16 * CAP + pos] = sc[j]; cidx[q16 * CAP + pos] = (unsigned short)(key0 + 4 * g4 + j);
                                }
                            }
                        }
                        __syncthreads();
                        const bool last = (r == nrounds - 1);
#pragma unroll 1
                        for (int k = 0; k < 2; ++k) { const int qq = 2 * wave + k; const int c = (int)cnt[qq];
#ifndef NO_REBUILD
                            if (c > 512 || (last && c > 256)) { const float t = topk_rebuild(cval + qq * CAP, cidx + qq * CAP, hist, c, lane); if (lane == 0) { cnt[qq] = 256u; tau[qq] = t; } }
#endif
 }
                        __syncthreads();
                    }
                } else {
                    for (int i = tid; i < 16 * 256; i += 512) cidx[(i >> 8) * CAP + (i & 255)] = (unsigned short)(i & 255);
                    __syncthreads();
                }
                const int nsel = N < 256 ? N : 256;
#pragma unroll 1
                for (int k = 0; k < 2; ++k) { const int qq = 2 * wave + k;
#ifndef NO_ATTNQ
                    attn_query(tok0 + qq, nsel, keybase, cidx + qq * CAP, (LAS float*)(lds + L_VAL) + wave * 2048, (LAS float*)hist, QB, KB, VB, AO, lane);
#endif
 }
            }
        }
        for (;;) {
            __syncthreads();
            if (tid == 0) *itemw = (int)atomicAdd(CTL + 3072 + 64 * x_xi, 1u);
            __syncthreads();
            const int item = *itemw;
            if (item >= N_CONV) break;
            {
                const int tok0 = (x_xi + x_nx * (item >> 2)) * 256 + (item & 3) * 64;
                __syncthreads();
                for (int i = tid; i < 31 * 512 / 4; i += 512) ((LAS f32x4*)lds)[i] = ((const f32x4*)args.in[12])[i];
                __syncthreads();
                const int ch = 8 * lane;
                const f32x4 cb0 = *(const f32x4*)(args.in[13] + ch), cb1 = *(const f32x4*)(args.in[13] + ch + 4);
                const f32x4 lg0 = *(const f32x4*)(args.in[14] + ch), lg1 = *(const f32x4*)(args.in[14] + ch + 4);
                const f32x4 lb0 = *(const f32x4*)(args.in[15] + ch), lb1 = *(const f32x4*)(args.in[15] + ch + 4);
#pragma unroll 1
                for (int tt = 0; tt < 8; ++tt) {
                    const int tok = tok0 + wave * 8 + tt;
                    const bool smp = tok >= NPR; const int sb = (tok - NPR) >> 6; const int j = smp ? ((tok - NPR) & 63) : (tok & (TPR - 1));
                    float a[8] = {cb0.x, cb0.y, cb0.z, cb0.w, cb1.x, cb1.y, cb1.z, cb1.w};
#pragma unroll 1
                    for (int w = 0; w < 31; ++w) {
                        const int rr = j + w - 30;
                        float x[8];
                        if (rr >= 0) { const int st = tok + w - 30; const bf16* xp = CB + (size_t)st * 512 + ch;
                            if ((st >> 8) != (tok >> 8)) { const int p = st >> 8; xp = (const bf16*)(ws + ((p >> 5) ? WS_HALO_B : WS_HALO_A)) + (size_t)((p & 31) * 30 + (st & 255) - 226) * 512 + ch; }
                            const v4u xv = *(const v4u*)xp;
                            x[0] = bflo(xv.x); x[1] = bfhi(xv.x); x[2] = bflo(xv.y); x[3] = bfhi(xv.y); x[4] = bflo(xv.z); x[5] = bfhi(xv.z); x[6] = bflo(xv.w); x[7] = bfhi(xv.w); }
                        else if (smp) { const float* sp = args.in[5] + (size_t)(sb * 30 + j + w) * 512 + ch; const f32x4 s0 = *(const f32x4*)sp, s1 = *(const f32x4*)(sp + 4);
                            x[0] = s0.x; x[1] = s0.y; x[2] = s0.z; x[3] = s0.w; x[4] = s1.x; x[5] = s1.y; x[6] = s1.z; x[7] = s1.w; }
                        else continue;
                        const f32x4 k0 = *(const LAS f32x4*)(lds + (size_t)(w * 512 + ch) * 4), k1 = *(const LAS f32x4*)(lds + (size_t)(w * 512 + ch + 4) * 4);
                        a[0] += x[0] * k0.x; a[1] += x[1] * k0.y; a[2] += x[2] * k0.z; a[3] += x[3] * k0.w; a[4] += x[4] * k1.x; a[5] += x[5] * k1.y; a[6] += x[6] * k1.z; a[7] += x[7] * k1.w;
                    }
                    float s = ((a[0] + a[1]) + (a[2] + a[3])) + ((a[4] + a[5]) + (a[6] + a[7]));
                    const float mean = wave_sum(s) * (1.0f / 512.0f);
                    float q = 0.f;
#pragma unroll
                    for (int i = 0; i < 8; ++i) { a[i] -= mean; q += a[i] * a[i]; }
                    const float rs = 1.0f / sqrtf(wave_sum(q) * (1.0f / 512.0f) + EPS);
                    const float gg[8] = {lg0.x, lg0.y, lg0.z, lg0.w, lg1.x, lg1.y, lg1.z, lg1.w}, bb[8] = {lb0.x, lb0.y, lb0.z, lb0.w, lb1.x, lb1.y, lb1.z, lb1.w};
#pragma unroll
                    for (int i = 0; i < 8; ++i) a[i] = siluf_(a[i] * rs * gg[i] + bb[i]);
                    v4u o; o.x = cvt_pk_bf16(a[0], a[1]); o.y = cvt_pk_bf16(a[2], a[3]); o.z = cvt_pk_bf16(a[4], a[5]); o.w = cvt_pk_bf16(a[6], a[7]);
                    *(v4u*)(CA + (size_t)tok * 512 + ch) = o;
                }
            }
        }
    }
    GSYNC();
    if (PHMASK & (1 << 5)) {
        pg8::Gemm g{AO, WAOT, CA, WCOT, NTOK, 1024, 512}; pg8::XcdOrder S; S.init(NTOK, 1024, x_xi, x_nx, x_nloc, x_r, 1);
        EpiMerge E{GATE, MG};
        pg8::gemm_phase<EpiMerge, pg8::XcdOrder, true, true>(lds, g, S, E);
    }
    GSYNC();
    if (PHMASK & (1 << 6)) {
        pg8::Gemm g{MG, WOT, MG, WOT, NTOK, 1024, 1024}; pg8::XcdOrder S; S.init(NTOK, 1024, x_xi, x_nx, x_nloc, x_r, 0);
        EpiResid E{H, H + (size_t)NPR * DM, H, XB, SSQ2, 1.0f};
        pg8::gemm_phase<EpiResid, pg8::XcdOrder, true, true>(lds, g, S, E);
    }
    GSYNC();
    if (PHMASK & (1 << 7)) {
        pg8::Gemm g{XB, W2T, XB, W2T, NTOK, 2 * DFF, 1024}; pg8::XcdOrder S; S.init(NTOK, 2 * DFF, x_xi, x_nx, x_nloc, x_r, 0);
        EpiSwiglu E{ACT, nullptr, SSQ2};
        pg8::gemm_phase<EpiSwiglu, pg8::XcdOrder, true, true>(lds, g, S, E);
    }
    GSYNC();
    if (PHMASK & (1 << 8)) {
        pg8::Gemm g{ACT, W2OT, ACT, W2OT, NTOK, 1024, DFF}; pg8::XcdOrder S; S.init(NTOK, 1024, x_xi, x_nx, x_nloc, x_r, 0);
        EpiResid E{H, H + (size_t)NPR * DM, H, nullptr, SSQ3, 0.5f};
        pg8::gemm_phase<EpiResid, pg8::XcdOrder, true, true>(lds, g, S, E);
    }
    GSYNC();
    if (PHMASK & (1 << 9)) for (int jr = x_r * NWAVES + wave; jr < x_T * 256; jr += x_nloc * NWAVES) {
        const int row = (x_xi + x_nx * (jr >> 8)) * 256 + (jr & 255);
        const float rs = row_rstd16(SSQ3, row);
        float* hr = H + (size_t)row * DM;
#pragma unroll
        for (int j = 0; j < 4; ++j) { f32x4 v = *(const f32x4*)(hr + 4 * lane + 256 * j); const f32x4 g = *(const f32x4*)(args.in[22] + 4 * lane + 256 * j);
            v = v * rs * g; *(f32x4*)(hr + 4 * lane + 256 * j) = v; }
    }
}

#undef ws
#undef out
#undef H
extern "C" void kernel_launch(void* const* d_in, const int* in_sizes, int n_in, void* d_out, int out_size, void* d_ws, size_t ws_size, hipStream_t stream) {
    static int grid = 0;
    if (grid == 0) {
        if (n_in != 23 || (size_t)out_size != O_END || ws_size < WS_END) { fprintf(stderr, "kernel_launch: unexpected shapes n_in %d out %d ws %zu\n", n_in, out_size, ws_size); grid = -1; return; }
        int dev = 0, cus = 0, per_cu = 0;
        hipGetDevice(&dev); hipDeviceGetAttribute(&cus, hipDeviceAttributeMultiprocessorCount, dev);
        if (hipFuncSetAttribute((const void*)mega_fwd, hipFuncAttributeMaxDynamicSharedMemorySize, LDS_BYTES) != hipSuccess) { fprintf(stderr, "kernel_launch: hipFuncSetAttribute failed\n"); grid = -1; return; }
        hipOccupancyMaxActiveBlocksPerMultiprocessor(&per_cu, (const void*)mega_fwd, 512, LDS_BYTES);
        (void)hipGetLastError();
        if (per_cu < 1) per_cu = 1;
        grid = cus;
        if (grid <= 0) grid = 256;
    }
    if (grid < 0) return;
    hipMemsetAsync((char*)d_ws + WS_CTL, 0, 64 * 1024, stream);
    Args a{};
    for (int i = 0; i < 23; ++i) a.in[i] = (const float*)d_in[i];
    a.out = (float*)d_out; a.ws = (unsigned char*)d_ws;
    for (int i = 0; i < 32; ++i) a.invf[i] = std::pow(10000.0, -(double)i / 32.0);
    void* kargs[] = {&a};
    hipError_t e = hipLaunchCooperativeKernel((const void*)mega_fwd, dim3(grid), dim3(512), kargs, LDS_BYTES, stream);
    if (e != hipSuccess) fprintf(stderr, "cooperative launch failed: %s (grid %d)\n", hipGetErrorString(e), grid);
}
```

```cpp
#include <hip/hip_runtime.h>
#include <hip/hip_cooperative_groups.h>
#include <cstdio>
#include <cstdint>
#include <cmath>
namespace cg = cooperative_groups;
namespace pg8 {
#define PG8_LAS __attribute__((address_space(3)))
typedef unsigned short bf16_t;
typedef short bf16x8 __attribute__((ext_vector_type(8)));
typedef float f32x4 __attribute__((ext_vector_type(4)));
typedef unsigned u32x4 __attribute__((ext_vector_type(4)));
constexpr int BM = 256, BK = 64, HALF = 128, HTB = HALF * BK * 2  , STAGE_BYTES = 8 * HTB, NXCD = 8, WGM = 8;

__host__ __device__ __forceinline__ int lds_byte(int r, int c) { const int st = (r >> 4) * 2 + (c >> 5), rr = r & 15, cc = c & 31, ob = rr * 64 + cc * 2; return st * 1024 + (ob ^ (((ob >> 9) & 1) << 5)); }
__host__ __device__ __forceinline__ void stage_rc(int b, int& R, int& C) { const int st = b / 1024, sb = b % 1024, swz = sb ^ (((sb >> 9) & 1) << 5); R = (st >> 1) * 16 + swz / 64; C = (st & 1) * 32 + (swz % 64) / 2; }
__host__ __device__ __forceinline__ int perm32(int rho) { const int n = rho >> 4, i = rho & 15; return 8 * (i >> 2) + 4 * n + (i & 3); }


struct Unit { int pm, pn, z, k0, nt, part; };
struct Gemm { const bf16_t* A; const bf16_t* Bt; const bf16_t* A2; const bf16_t* Bt2; int M, N, K; };

struct StaticOrder {
    int nM, nN, nwg, G, c, dbl;
    __host__ __device__ void init(int M, int N, int G_, int c_, int dbl_) { nM = M / BM; nN = N / BM; nwg = nM * nN; G = G_; c = c_; dbl = dbl_; }
    __host__ __device__ bool next(int i, Unit& u) const {
        const int ii = dbl ? (i >> 1) : i;
        const long L = (long)ii * G + c; if (L >= nwg) return false;
        int wgid = (int)L; { const int q = nwg / NXCD, r = nwg % NXCD, xcd = wgid % NXCD, off = wgid / NXCD; wgid = (xcd < r ? xcd * (q + 1) : r * (q + 1) + (xcd - r) * q) + off; }
        const int nig = WGM * nN, gid = wgid / nig, fm = gid * WGM, gsz = (nM - fm) < WGM ? (nM - fm) : WGM;
        u.pm = fm + ((wgid % nig) % gsz); u.pn = (wgid % nig) / gsz; u.z = dbl ? (i & 1) : 0; u.k0 = 0; u.nt = 0; u.part = 0; return true;
    }
    __device__ __forceinline__ void a_ready(const Unit&) const {}
    __device__ __forceinline__ void done(const Unit&) const {}
};

__device__ __forceinline__ int xcd_tile(int xi, int nx, int t) {
    if (nx != 8) return xi + nx * t;
    if (t >= 8) return 64 + xi;
    const int sg = t & 3; return (t >> 2) * 32 + sg * 8 + ((sg & 1) ? 7 - xi : xi);
}
struct XcdOrder {
    int nN, T, xi, nx, nloc, r, dbl, ntd, split;
    __device__ __forceinline__ void init(int M, int N, int K, int xi_, int nx_, int nloc_, int r_, int dbl_, int split_) { const int nM = M / BM; nN = N / BM; xi = xi_; nx = nx_; nloc = nloc_; r = r_; dbl = dbl_; ntd = K / BK;
        T = nx == 8 ? 9 : (nM - xi + nx - 1) / nx; split = (split_ && nx == 8 && nN == 4 && (ntd == 44 || ntd == 16)) ? 1 : 0; }
    __device__ __forceinline__ bool next(int i, Unit& u) const {
        const int ii = dbl ? (i >> 1) : i;
        const int j = ii * nloc + r; u.z = dbl ? (i & 1) : 0; u.k0 = 0; u.nt = ntd; u.part = 0;
        if (!split) { if (j >= T * nN) return false; u.pn = j / T; u.pm = xcd_tile(xi, nx, j - u.pn * T); return true; }
        const int nfull = (T - 1) * nN;
        if (j < nfull) { u.pn = j / (T - 1); u.pm = xcd_tile(xi, nx, j - u.pn * (T - 1)); return true; }
        const int jj = j - nfull, nch = ntd == 44 ? 8 : 4;
        if (jj >= nN * nch) return false;
        u.pn = jj / nch; const int c = jj - u.pn * nch; u.pm = xcd_tile(xi, nx, T - 1); u.part = 1 + c;
        if (ntd == 44) { u.k0 = c < 6 ? 6 * c : 36 + 4 * (c - 6); u.nt = c < 6 ? 6 : 4; } else { u.k0 = 4 * c; u.nt = 4; }
        return true;
    }
    __device__ __forceinline__ void a_ready(const Unit&) const {}
    __device__ __forceinline__ void done(const Unit&) const {}
};
typedef float f32x2_t_ __attribute__((ext_vector_type(2)));
typedef __bf16 bf16x2_t_ __attribute__((ext_vector_type(2)));
__device__ __forceinline__ unsigned cvt_pk_bf16(float lo, float hi) { const f32x2_t_ v = {lo, hi}; const bf16x2_t_ b = __builtin_convertvector(v, bf16x2_t_); return __builtin_bit_cast(unsigned, b); }

template <class Epi, class Sched, bool ALIGN_EPI = false, bool SP2 = false>
__device__ __forceinline__ void gemm_phase(PG8_LAS unsigned char* lds, const Gemm g, const Sched& S, const Epi& E) {
    int tid_ = threadIdx.x; asm volatile("" : "+v"(tid_));
    const int tid = tid_, wid = __builtin_amdgcn_readfirstlane(tid >> 6), lane = tid & 63, wr = wid >> 2, wc = wid & 3, fr = lane & 15, fq = lane >> 4;
    const int K = g.K, nt = K / BK;
    unsigned voffA[2], voffB[2];
#pragma unroll
    for (int i = 0; i < 2; ++i) { int R, C; stage_rc(tid * 16 + i * 8192, R, C); const int Rb = Epi::PERM ? ((R & ~31) + perm32(R & 31)) : R;
        voffA[i] = (unsigned)(R * K + C) * 2u; voffB[i] = (unsigned)(Rb * K + C) * 2u; }
    const size_t kstep = (size_t)(BK * 2);
    const size_t hstep = (size_t)HALF * K * 2;
    const size_t tstep = 2 * hstep;
    const unsigned ldsw = (unsigned)wid * 1024u;
    const int aoff = lds_byte(wr * 64 + fr, fq * 8), boff = lds_byte(wc * 32 + fr, fq * 8);
#define PG8_SA(b, h) (((b) * 2 + (h)) * HTB)
#define PG8_SB(b, h) ((4 + (b) * 2 + (h)) * HTB)
#define PG8_STAGE(bufoff, gbase, voff) do { _Pragma("unroll") for (int _i = 0; _i < 2; ++_i) \
        __builtin_amdgcn_global_load_lds((const unsigned*)((const char*)(gbase) + (voff)[_i]), (PG8_LAS unsigned*)(lds + (bufoff) + ldsw + _i * 8192), 16, 0, 0); } while (0)
#define PG8_LDA(dst, b, h) do { _Pragma("unroll") for (int m = 0; m < 4; ++m) _Pragma("unroll") for (int k = 0; k < 2; ++k) dst[m][k] = *(const PG8_LAS bf16x8*)(lds + PG8_SA(b, h) + aoff + m * 2048 + k * 1024); } while (0)
#define PG8_LDB(dst, b, h) do { _Pragma("unroll") for (int n = 0; n < 2; ++n) _Pragma("unroll") for (int k = 0; k < 2; ++k) dst[n][k] = *(const PG8_LAS bf16x8*)(lds + PG8_SB(b, h) + boff + n * 2048 + k * 1024); } while (0)
#define PG8_MMA(ai, bj, At, Bt) do { __builtin_amdgcn_s_setprio(1); _Pragma("unroll") for (int m = 0; m < 4; ++m) _Pragma("unroll") for (int n = 0; n < 2; ++n) _Pragma("unroll") for (int k = 0; k < 2; ++k) \
        acc[ai][bj][m][n] = __builtin_amdgcn_mfma_f32_16x16x32_bf16(Bt[n][k], At[m][k], acc[ai][bj][m][n], 0, 0, 0); __builtin_amdgcn_s_setprio(0); } while (0)
#define PG8_WAIT_V(n) asm volatile("s_waitcnt vmcnt(" #n ")" ::: "memory")
#define PG8_WAIT_L(n) asm volatile("s_waitcnt lgkmcnt(" #n ")" ::: "memory")
#define PG8_BAR __builtin_amdgcn_s_barrier()
#define PG8_SCHED __builtin_amdgcn_sched_barrier(0)
    Unit cur, nxt; int ui = 0;
    if (!S.next(0, cur)) return;
    f32x4 acc[2][2][4][2];
#pragma unroll
    for (int a = 0; a < 2; ++a)
#pragma unroll
        for (int b = 0; b < 2; ++b)
#pragma unroll
            for (int m = 0; m < 4; ++m)
#pragma unroll
                for (int n = 0; n < 2; ++n) acc[a][b][m][n] = (f32x4){0.f, 0.f, 0.f, 0.f};
    bf16x8 At[4][2], B0[2][2], B1[2][2];
    const char* cA = (const char*)(cur.z ? g.A2 : g.A) + (size_t)cur.pm * tstep + (size_t)cur.k0 * kstep; const char* cB = (const char*)(cur.z ? g.Bt2 : g.Bt) + (size_t)cur.pn * tstep + (size_t)cur.k0 * kstep;
    S.a_ready(cur);
    if constexpr (SP2) {
        PG8_STAGE(PG8_SB(0, 0), cB, voffB); PG8_STAGE(PG8_SB(0, 1), cB + hstep, voffB); PG8_STAGE(PG8_SA(0, 0), cA, voffA); PG8_STAGE(PG8_SA(0, 1), cA + hstep, voffA);
        if (wr == 1) PG8_BAR;
        PG8_WAIT_V(2); PG8_BAR;
        PG8_STAGE(PG8_SB(1, 0), cB + kstep, voffB); PG8_STAGE(PG8_SA(1, 0), cA + kstep, voffA); PG8_STAGE(PG8_SB(1, 1), cB + hstep + kstep, voffB);
        PG8_WAIT_V(6); PG8_BAR;
    } else {
        PG8_STAGE(PG8_SB(0, 0), cB, voffB); PG8_STAGE(PG8_SA(0, 0), cA, voffA); PG8_STAGE(PG8_SB(0, 1), cB + hstep, voffB); PG8_STAGE(PG8_SA(0, 1), cA + hstep, voffA);
        if (wr == 1) PG8_BAR;
        PG8_WAIT_V(4); PG8_BAR;
        PG8_STAGE(PG8_SB(1, 0), cB + kstep, voffB); PG8_STAGE(PG8_SA(1, 0), cA + kstep, voffA); PG8_STAGE(PG8_SB(1, 1), cB + hstep + kstep, voffB);
        PG8_WAIT_V(6); PG8_BAR;
    }
    for (;;) {
        const bool has_next = S.next(ui + 1, nxt);
        const char* nA = has_next ? (const char*)(nxt.z ? g.A2 : g.A) + (size_t)nxt.pm * tstep + (size_t)nxt.k0 * kstep : cA; const char* nB = has_next ? (const char*)(nxt.z ? g.Bt2 : g.Bt) + (size_t)nxt.pn * tstep + (size_t)nxt.k0 * kstep : cB;
        const int unt = cur.nt;
        for (int t = 0; t < unt; t += 2) {
            const bool last = (t == unt - 2);
            const char* a1 = cA + (size_t)(t + 1) * kstep;
            const char* a2 = last ? nA : cA + (size_t)(t + 2) * kstep; const char* b2 = last ? nB : cB + (size_t)(t + 2) * kstep;
            const char* a3 = a2 + kstep; const char* b3 = b2 + kstep;
            if (last && has_next) S.a_ready(nxt);
            if constexpr (SP2) {
            PG8_LDB(B0, 0, 0); PG8_LDB(B1, 0, 1); PG8_SCHED; PG8_LDA(At, 0, 0); PG8_STAGE(PG8_SA(1, 1), a1 + hstep, voffA);
            PG8_WAIT_V(8); PG8_WAIT_L(0); PG8_BAR; PG8_MMA(0, 0, At, B0); PG8_MMA(0, 1, At, B1); PG8_BAR; PG8_SCHED;
            PG8_LDA(At, 0, 1); PG8_STAGE(PG8_SB(0, 0), b2, voffB); PG8_STAGE(PG8_SB(0, 1), b2 + hstep, voffB); PG8_STAGE(PG8_SA(0, 0), a2, voffA);
            PG8_WAIT_V(8); PG8_WAIT_L(0); PG8_BAR; PG8_MMA(1, 0, At, B0); PG8_MMA(1, 1, At, B1); PG8_BAR; PG8_SCHED;
            PG8_LDB(B0, 1, 0); PG8_LDB(B1, 1, 1); PG8_SCHED; PG8_LDA(At, 1, 0); PG8_STAGE(PG8_SA(0, 1), a2 + hstep, voffA);
            PG8_WAIT_V(8); PG8_WAIT_L(0); PG8_BAR; PG8_MMA(0, 0, At, B0); PG8_MMA(0, 1, At, B1); PG8_BAR; PG8_SCHED;
            PG8_LDA(At, 1, 1); PG8_STAGE(PG8_SB(1, 0), b3, voffB); PG8_STAGE(PG8_SB(1, 1), b3 + hstep, voffB); PG8_STAGE(PG8_SA(1, 0), a3, voffA);
            PG8_WAIT_V(8); PG8_WAIT_L(0); PG8_BAR; PG8_MMA(1, 0, At, B0); PG8_MMA(1, 1, At, B1); PG8_BAR; PG8_SCHED;
            } else {
            PG8_LDB(B0, 0, 0); PG8_SCHED; PG8_LDA(At, 0, 0); PG8_STAGE(PG8_SA(1, 1), a1 + hstep, voffA);
            PG8_WAIT_L(8); PG8_BAR; PG8_WAIT_L(0); PG8_MMA(0, 0, At, B0); PG8_BAR; PG8_SCHED;
            PG8_LDB(B1, 0, 1); PG8_STAGE(PG8_SB(0, 0), b2, voffB);
            PG8_BAR; PG8_WAIT_L(0); PG8_MMA(0, 1, At, B1); PG8_BAR;
            PG8_LDA(At, 0, 1); PG8_STAGE(PG8_SA(0, 0), a2, voffA);
            PG8_BAR; PG8_WAIT_L(0); PG8_MMA(1, 0, At, B0); PG8_BAR; PG8_SCHED;
            PG8_STAGE(PG8_SB(0, 1), b2 + hstep, voffB);
            PG8_WAIT_V(6); PG8_BAR; PG8_MMA(1, 1, At, B1); PG8_BAR;
            PG8_LDB(B0, 1, 0); PG8_SCHED; PG8_LDA(At, 1, 0); PG8_STAGE(PG8_SA(0, 1), a2 + hstep, voffA);
            PG8_WAIT_L(8); PG8_BAR; PG8_WAIT_L(0); PG8_MMA(0, 0, At, B0); PG8_BAR; PG8_SCHED;
            PG8_LDB(B1, 1, 1); PG8_STAGE(PG8_SB(1, 0), b3, voffB);
            PG8_BAR; PG8_WAIT_L(0); PG8_MMA(0, 1, At, B1); PG8_BAR;
            PG8_LDA(At, 1, 1); PG8_STAGE(PG8_SA(1, 0), a3, voffA);
            PG8_BAR; PG8_WAIT_L(0); PG8_MMA(1, 0, At, B0); PG8_BAR; PG8_SCHED;
            PG8_STAGE(PG8_SB(1, 1), b3 + hstep, voffB);
            PG8_WAIT_V(6); PG8_BAR; PG8_MMA(1, 1, At, B1); PG8_BAR;
            }
        }
        if constexpr (ALIGN_EPI) { if (wr == 0) PG8_BAR; }
        if constexpr (!Epi::AFTER_DRAIN) { E(acc, cur, wr, wc, fr, fq); S.done(cur); }
        if (!has_next) break;
#pragma unroll
        for (int a = 0; a < 2; ++a)
#pragma unroll
            for (int b = 0; b < 2; ++b)
#pragma unroll
                for (int m = 0; m < 4; ++m)
#pragma unroll
                    for (int n = 0; n < 2; ++n) acc[a][b][m][n] = (f32x4){0.f, 0.f, 0.f, 0.f};
        cur = nxt; cA = nA; cB = nB; ++ui;
        if constexpr (ALIGN_EPI) { if (wr == 1) PG8_BAR; }
    }
    PG8_WAIT_V(0);
    if constexpr (!ALIGN_EPI) { if (wr == 0) PG8_BAR; }
    PG8_BAR;
    if constexpr (Epi::AFTER_DRAIN) { E.fused(acc, cur, wr, wc, fr, fq, lds, wid, lane); S.done(cur); }
#undef PG8_SA
#undef PG8_SB
#undef PG8_STAGE
#undef PG8_LDA
#undef PG8_LDB
#undef PG8_MMA
#undef PG8_WAIT_V
#undef PG8_WAIT_L
#undef PG8_BAR
#undef PG8_SCHED
}
}

#define GAS __attribute__((address_space(1)))
#define LAS __attribute__((address_space(3)))
typedef unsigned short bf16;
typedef unsigned v4u __attribute__((ext_vector_type(4)));
typedef unsigned v2u __attribute__((ext_vector_type(2)));
typedef float f32x4 __attribute__((ext_vector_type(4)));
typedef short bf16x8 __attribute__((ext_vector_type(8)));
typedef _Float16 h16x8 __attribute__((ext_vector_type(8)));
using pg8::cvt_pk_bf16;

constexpr int DM = 1024, NTOK = 18432, NPR = 16384, TPR = 8192, TSM = 64, PAST = 1024, LSM = 1088;
constexpr int DFF = 2816, NIN = 4608, NWAVES = 8;
constexpr float EPS = 1e-6f;
constexpr size_t KiB = 1024, MiB = 1u << 20;
constexpr size_t WS_CTL = 0;
constexpr size_t WS_RSTD0 = 64 * KiB;
constexpr size_t WS_WI = 192 * KiB;
constexpr size_t WS_SSQ1 = 768 * KiB;
constexpr size_t WS_SSQ2 = 1920 * KiB;
constexpr size_t WS_SSQ3 = WS_SSQ1;
constexpr size_t WS_HALO_A = 3 * MiB;
constexpr size_t WS_COS = 4 * MiB + 256 * KiB;
constexpr size_t WS_SIN = 5 * MiB + 256 * KiB;
constexpr size_t WS_W1T = 6 * MiB + 256 * KiB;
constexpr size_t WS_W1OT = WS_W1T + 11 * MiB;
constexpr size_t WS_WINT = WS_W1OT + 5 * MiB + 512 * KiB;
constexpr size_t WS_WCOT = WS_WINT + 9 * MiB;
constexpr size_t WS_WAOT = WS_WCOT + 1 * MiB;
constexpr size_t WS_WOT = WS_WAOT + 1 * MiB;
constexpr size_t WS_W2T = WS_WOT + 2 * MiB;
constexpr size_t WS_W2OT = WS_W2T + 11 * MiB;
constexpr size_t WS_XB = WS_W2OT + 5 * MiB + 512 * KiB;
constexpr size_t WS_AO = WS_XB, WS_CA = WS_XB + 18 * MiB;
constexpr size_t WS_ACT = WS_XB + 36 * MiB;
constexpr size_t WS_GATE = WS_ACT, WS_C = WS_ACT + 72 * MiB;
constexpr size_t WS_Q = WS_ACT + 99 * MiB;
constexpr size_t WS_QI = WS_Q + 18 * MiB;
constexpr size_t WS_MERGED = WS_Q;
constexpr size_t WS_KB = WS_QI + 18 * MiB;
constexpr size_t WS_VB = WS_KB + 12 * MiB + 512 * KiB;
constexpr size_t WS_KIB = WS_VB + 12 * MiB + 512 * KiB;
constexpr size_t WS_HALO_B = WS_KIB + 6 * MiB + 256 * KiB;
constexpr size_t WS_END = WS_HALO_B + 1 * MiB;
static_assert(WS_END <= 256 * MiB, "workspace map");
constexpr size_t O_Y = 0, O_KP = 18874368, O_VP = O_KP + 2097152, O_IP = O_VP + 2097152, O_CP = O_IP + 1048576, O_KS = O_CP + 30720,
                 O_VS = O_KS + 262144, O_IS = O_VS + 262144, O_CS = O_IS + 131072, O_END = O_CS + 491520;
constexpr int LDS_BYTES = 147456;
constexpr int CAP = 1280;
constexpr int L_VAL = 0, L_IDX = 16 * CAP * 4, L_HIST = L_IDX + 16 * CAP * 2, L_CNT = L_HIST + 512, L_TAU = L_CNT + 64, L_ITEM = L_CNT + 128;
static_assert(L_ITEM + 64 <= 131072, "P4 LDS map");

#define LDS_WAIT() asm volatile("s_waitcnt lgkmcnt(0)" ::: "memory")
__device__ __forceinline__ unsigned f2bf(float f) { unsigned u = __builtin_bit_cast(unsigned, f); return (u + 0x7fffu + ((u >> 16) & 1u)) >> 16; }
__device__ __forceinline__ unsigned pk2(float lo, float hi) { return f2bf(lo) | (f2bf(hi) << 16); }
__device__ __forceinline__ unsigned pkh(float lo, float hi) { _Float16 a = (_Float16)lo, b = (_Float16)hi; return (unsigned)__builtin_bit_cast(unsigned short, a) | ((unsigned)__builtin_bit_cast(unsigned short, b) << 16); }
__device__ __forceinline__ float bflo(unsigned v) { return __uint_as_float(v << 16); }
__device__ __forceinline__ float bfhi(unsigned v) { return __uint_as_float(v & 0xffff0000u); }
__device__ __forceinline__ float wave_sum(float v) {
#pragma unroll
    for (int o = 1; o < 64; o <<= 1) v += __shfl_xor(v, o);
    return v;
}
__device__ __forceinline__ float sigmoidf_(float x) { return __builtin_amdgcn_rcpf(1.0f + __expf(-x)); }
__device__ __forceinline__ float siluf_(float x) { return x * sigmoidf_(x); }

struct Args { const float* in[23]; float* out; unsigned char* ws; double invf[32]; };

__device__ __forceinline__ float row_rstd16(const float* ssq, int row) {
    const f32x4* p = (const f32x4*)(ssq + (size_t)row * 16);
    f32x4 a = p[0], b = p[1], c = p[2], d = p[3];
    float s = ((a.x + a.y) + (a.z + a.w)) + ((b.x + b.y) + (b.z + b.w)) + ((c.x + c.y) + (c.z + c.w)) + ((d.x + d.y) + (d.z + d.w));
    return 1.0f / sqrtf(s * (1.0f / 1024.0f) + EPS);
}

struct EpiSwiglu {
    static constexpr bool PERM = true, AFTER_DRAIN = false;
    bf16* act; const float* rstd; const float* ssq;
    __device__ __forceinline__ void operator()(const f32x4 (&acc)[2][2][4][2], const pg8::Unit& u, int wr, int wc, int fr, int fq) const {
        asm volatile("" : "+v"(fr), "+v"(fq));
#pragma unroll
        for (int ai = 0; ai < 2; ++ai)
#pragma unroll
            for (int m = 0; m < 4; ++m) {
                const int row = u.pm * 256 + ai * 128 + wr * 64 + m * 16 + fr;
                const float rs = rstd ? rstd[row] : row_rstd16(ssq, row);
                float o[8];
#pragma unroll
                for (int n = 0; n < 2; ++n)
#pragma unroll
                    for (int j = 0; j < 4; ++j) { const float a = acc[ai][0][m][n][j] * rs, b = acc[ai][1][m][n][j] * rs; o[n * 4 + j] = siluf_(a) * b; }
                v4u w; w.x = cvt_pk_bf16(o[0], o[1]); w.y = cvt_pk_bf16(o[2], o[3]); w.z = cvt_pk_bf16(o[4], o[5]); w.w = cvt_pk_bf16(o[6], o[7]);
                *(v4u*)(act + (size_t)row * DFF + u.pn * 128 + wc * 32 + fq * 8) = w;
            }
    }
};

struct EpiResid {
    static constexpr bool PERM = true, AFTER_DRAIN = false;
    const float* baseP; const float* baseS;
    float* h; bf16* hb; float* ssq; float scale; bf16* part;
    __device__ __forceinline__ void operator()(const f32x4 (&acc)[2][2][4][2], const pg8::Unit& u, int wr, int wc, int fr, int fq) const {
        asm volatile("" : "+v"(fr), "+v"(fq));
#pragma unroll
        for (int ai = 0; ai < 2; ++ai)
#pragma unroll
            for (int m = 0; m < 4; ++m) {
                const int row = u.pm * 256 + ai * 128 + wr * 64 + m * 16 + fr;
                if (u.part) {
                    bf16* pp = part + ((size_t)((u.pm - 64) * 8 + (u.part - 1)) * 256 + (row & 255)) * DM + u.pn * 256 + wc * 32 + fq * 8;
#pragma unroll
                    for (int bj = 0; bj < 2; ++bj) { v4u w; w.x = cvt_pk_bf16(acc[ai][bj][m][0].x, acc[ai][bj][m][0].y); w.y = cvt_pk_bf16(acc[ai][bj][m][0].z, acc[ai][bj][m][0].w);
                        w.z = cvt_pk_bf16(acc[ai][bj][m][1].x, acc[ai][bj][m][1].y); w.w = cvt_pk_bf16(acc[ai][bj][m][1].z, acc[ai][bj][m][1].w); *(v4u*)(pp + bj * 128) = w; }
                    continue;
                }
                const float* bp = row < NPR ? baseP + (size_t)row * DM : baseS + (size_t)(row - NPR) * DM;
                float ss = 0.f;
#pragma unroll
                for (int bj = 0; bj < 2; ++bj) {
                    const int col = u.pn * 256 + bj * 128 + wc * 32 + fq * 8;
                    f32x4 v0 = *(const f32x4*)(bp + col), v1 = *(const f32x4*)(bp + col + 4);
                    v0 = v0 + acc[ai][bj][m][0] * scale; v1 = v1 + acc[ai][bj][m][1] * scale;
                    *(f32x4*)(h + (size_t)row * DM + col) = v0; *(f32x4*)(h + (size_t)row * DM + col + 4) = v1;
                    ss += (v0.x * v0.x + v0.y * v0.y) + (v0.z * v0.z + v0.w * v0.w) + (v1.x * v1.x + v1.y * v1.y) + (v1.z * v1.z + v1.w * v1.w);
                    if (hb) { v4u w; w.x = cvt_pk_bf16(v0.x, v0.y); w.y = cvt_pk_bf16(v0.z, v0.w); w.z = cvt_pk_bf16(v1.x, v1.y); w.w = cvt_pk_bf16(v1.z, v1.w);
                              *(v4u*)(hb + (size_t)row * DM + col) = w; }
                }
                ss += __shfl_xor(ss, 16); ss += __shfl_xor(ss, 32);
                if (fq == 0) ssq[(size_t)row * 16 + u.pn * 4 + wc] = ss;
            }
    }
};

struct EpiResidNorm {
    static constexpr bool PERM = true, AFTER_DRAIN = false;
    float* h; float* ssq; bf16* part; const float* gfn; unsigned* ctr; int fuse;
    __device__ __forceinline__ void operator()(f32x4 (&acc)[2][2][4][2], const pg8::Unit& u, int wr, int wc, int fr, int fq) const {
        asm volatile("" : "+v"(fr), "+v"(fq));
        if (u.part) {
#pragma unroll
            for (int ai = 0; ai < 2; ++ai)
#pragma unroll
                for (int m = 0; m < 4; ++m) { const int row = u.pm * 256 + ai * 128 + wr * 64 + m * 16 + fr;
                    bf16* pp = part + ((size_t)((u.pm - 64) * 8 + (u.part - 1)) * 256 + (row & 255)) * DM + u.pn * 256 + wc * 32 + fq * 8;
#pragma unroll
                    for (int bj = 0; bj < 2; ++bj) { v4u w; w.x = cvt_pk_bf16(acc[ai][bj][m][0].x, acc[ai][bj][m][0].y); w.y = cvt_pk_bf16(acc[ai][bj][m][0].z, acc[ai][bj][m][0].w);
                        w.z = cvt_pk_bf16(acc[ai][bj][m][1].x, acc[ai][bj][m][1].y); w.w = cvt_pk_bf16(acc[ai][bj][m][1].z, acc[ai][bj][m][1].w); *(v4u*)(pp + bj * 128) = w; } }
            return;
        }
#pragma unroll
        for (int ai = 0; ai < 2; ++ai)
#pragma unroll
            for (int m = 0; m < 4; ++m) {
                const int row = u.pm * 256 + ai * 128 + wr * 64 + m * 16 + fr;
                float ss = 0.f;
#pragma unroll
                for (int bj = 0; bj < 2; ++bj) {
                    float* hp = h + (size_t)row * DM + u.pn * 256 + bj * 128 + wc * 32 + fq * 8;
                    f32x4 v0 = *(const f32x4*)hp, v1 = *(const f32x4*)(hp + 4);
                    v0 = v0 + acc[ai][bj][m][0] * 0.5f; v1 = v1 + acc[ai][bj][m][1] * 0.5f;
                    acc[ai][bj][m][0] = v0; acc[ai][bj][m][1] = v1;
                    if (!fuse) { *(f32x4*)hp = v0; *(f32x4*)(hp + 4) = v1; }
                    ss += (v0.x * v0.x + v0.y * v0.y) + (v0.z * v0.z + v0.w * v0.w) + (v1.x * v1.x + v1.y * v1.y) + (v1.z * v1.z + v1.w * v1.w);
                }
                ss += __shfl_xor(ss, 16); ss += __shfl_xor(ss, 32);
                if (fq == 0) ssq[(size_t)row * 16 + u.pn * 4 + wc] = ss;
            }
        if (!fuse) return;
        asm volatile("s_waitcnt vmcnt(0)" ::: "memory"); __syncthreads();
        if (threadIdx.x == 0) { unsigned* cp = ctr + 64 * u.pm; __hip_atomic_fetch_add(cp, 1u, __ATOMIC_RELAXED, __HIP_MEMORY_SCOPE_AGENT); unsigned sp = 0u;
            while (__hip_atomic_load(cp, __ATOMIC_RELAXED, __HIP_MEMORY_SCOPE_AGENT) < 4u) { __builtin_amdgcn_s_sleep(2); if (++sp > (1u << 22)) break; }
            __builtin_amdgcn_fence(__ATOMIC_ACQUIRE, "agent"); asm volatile("s_waitcnt vmcnt(0)" ::: "memory"); }
        __syncthreads();
        const int colg = u.pn * 256 + wc * 32 + fq * 8;
        const f32x4 g00 = *(const f32x4*)(gfn + colg), g01 = *(const f32x4*)(gfn + colg + 4), g10 = *(const f32x4*)(gfn + colg + 128), g11 = *(const f32x4*)(gfn + colg + 132);
#pragma unroll
        for (int ai = 0; ai < 2; ++ai)
#pragma unroll
            for (int m = 0; m < 4; ++m) {
                const int row = u.pm * 256 + ai * 128 + wr * 64 + m * 16 + fr;
                const float rs = row_rstd16(ssq, row);
                float* hp = h + (size_t)row * DM + colg;
                *(f32x4*)hp = acc[ai][0][m][0] * rs * g00; *(f32x4*)(hp + 4) = acc[ai][0][m][1] * rs * g01;
                *(f32x4*)(hp + 128) = acc[ai][1][m][0] * rs * g10; *(f32x4*)(hp + 132) = acc[ai][1][m][1] * rs * g11;
            }
    }
};

struct EpiMix {
    static constexpr bool PERM = true, AFTER_DRAIN = false;
    const float* ssq; const float* cosT; const float* sinT; const float* bgate;
    bf16* Q; unsigned short* QI; bf16* KB; bf16* VB; unsigned short* KIB; float* WI; bf16* C; bf16* G; float* out; unsigned char* wsb;
    __device__ __forceinline__ void operator()(const f32x4 (&acc)[2][2][4][2], const pg8::Unit& u, int wr, int wc, int fr, int fq) const {
        asm volatile("" : "+v"(fr), "+v"(fq));
        const int pn = u.pn;
        float rsv[8];
#pragma unroll
        for (int i8 = 0; i8 < 8; ++i8) rsv[i8] = ssq[u.pm * 256 + (i8 >> 2) * 128 + wr * 64 + (i8 & 3) * 16 + fr];
        f32x4 gb0 = {0.f, 0.f, 0.f, 0.f}, gb1 = gb0, gb2 = gb0, gb3 = gb0;
        if (pn >= 10) { const int colb = (pn - 10) * 256 + wc * 32 + fq * 8; gb0 = *(const f32x4*)(bgate + colb); gb1 = *(const f32x4*)(bgate + colb + 4); gb2 = *(const f32x4*)(bgate + colb + 128); gb3 = *(const f32x4*)(bgate + colb + 132); }
#pragma unroll
        for (int ai = 0; ai < 2; ++ai)
#pragma unroll
            for (int m = 0; m < 4; ++m) {
                const int row = u.pm * 256 + ai * 128 + wr * 64 + m * 16 + fr;
                const float rs = rsv[ai * 4 + m];
                const bool smp = row >= NPR;
                const int sb = (row - NPR) >> 6, sj = (row - NPR) & 63;
                const int pos = smp ? PAST + sj : (row & (TPR - 1));
                const int krow = smp ? NPR + sb * LSM + PAST + sj : row;
                float lo[8], hi[8];
#pragma unroll
                for (int n = 0; n < 2; ++n)
#pragma unroll
                    for (int j = 0; j < 4; ++j) { lo[n * 4 + j] = acc[ai][0][m][n][j] * rs; hi[n * 4 + j] = acc[ai][1][m][n][j] * rs; }
                const bool is_rope = (pn < 4) || (pn == 4 && wc < 2) || (pn == 5 && wc == 0);
                if (is_rope) {
                    const f32x4 c0 = *(const f32x4*)(cosT + pos * 32 + fq * 8), c1 = *(const f32x4*)(cosT + pos * 32 + fq * 8 + 4);
                    const f32x4 s0 = *(const f32x4*)(sinT + pos * 32 + fq * 8), s1 = *(const f32x4*)(sinT + pos * 32 + fq * 8 + 4);
                    const float cs[8] = {c0.x, c0.y, c0.z, c0.w, c1.x, c1.y, c1.z, c1.w}, sn[8] = {s0.x, s0.y, s0.z, s0.w, s1.x, s1.y, s1.z, s1.w};
#pragma unroll
                    for (int i = 0; i < 8; ++i) { const float a = lo[i], b = hi[i]; lo[i] = a * cs[i] - b * sn[i]; hi[i] = b * cs[i] + a * sn[i]; }
                    if (pn < 2) {
                        bf16* p = Q + (size_t)row * 512 + (4 * pn + wc) * 64 + fq * 8;
                        v4u w; w.x = cvt_pk_bf16(lo[0], lo[1]); w.y = cvt_pk_bf16(lo[2], lo[3]); w.z = cvt_pk_bf16(lo[4], lo[5]); w.w = cvt_pk_bf16(lo[6], lo[7]); *(v4u*)p = w;
                        w.x = cvt_pk_bf16(hi[0], hi[1]); w.y = cvt_pk_bf16(hi[2], hi[3]); w.z = cvt_pk_bf16(hi[4], hi[5]); w.w = cvt_pk_bf16(hi[6], hi[7]); *(v4u*)(p + 32) = w;
                    } else if (pn < 4) {
                        unsigned short* p = QI + (size_t)row * 512 + (4 * (pn - 2) + wc) * 64 + fq * 8;
                        v4u w; w.x = pkh(lo[0], lo[1]); w.y = pkh(lo[2], lo[3]); w.z = pkh(lo[4], lo[5]); w.w = pkh(lo[6], lo[7]); *(v4u*)p = w;
                        w.x = pkh(hi[0], hi[1]); w.y = pkh(hi[2], hi[3]); w.z = pkh(hi[4], hi[5]); w.w = pkh(hi[6], hi[7]); *(v4u*)(p + 32) = w;
                    } else if (pn == 4) {
                        float* o = out + (smp ? O_KS + (size_t)(row - NPR) * 128 : O_KP + (size_t)row * 128) + wc * 64 + fq * 8;
                        *(f32x4*)o = (f32x4){lo[0], lo[1], lo[2], lo[3]}; *(f32x4*)(o + 4) = (f32x4){lo[4], lo[5], lo[6], lo[7]};
                        *(f32x4*)(o + 32) = (f32x4){hi[0], hi[1], hi[2], hi[3]}; *(f32x4*)(o + 36) = (f32x4){hi[4], hi[5], hi[6], hi[7]};
                        bf16* p = KB + (size_t)krow * 128 + wc * 64 + fq * 8;
                        v4u w; w.x = cvt_pk_bf16(lo[0], lo[1]); w.y = cvt_pk_bf16(lo[2], lo[3]); w.z = cvt_pk_bf16(lo[4], lo[5]); w.w = cvt_pk_bf16(lo[6], lo[7]); *(v4u*)p = w;
                        w.x = cvt_pk_bf16(hi[0], hi[1]); w.y = cvt_pk_bf16(hi[2], hi[3]); w.z = cvt_pk_bf16(hi[4], hi[5]); w.w = cvt_pk_bf16(hi[6], hi[7]); *(v4u*)(p + 32) = w;
                    } else {
                        float* o = out + (smp ? O_IS + (size_t)(row - NPR) * 64 : O_IP + (size_t)row * 64) + fq * 8;
                        *(f32x4*)o = (f32x4){lo[0], lo[1], lo[2], lo[3]}; *(f32x4*)(o + 4) = (f32x4){lo[4], lo[5], lo[6], lo[7]};
                        *(f32x4*)(o + 32) = (f32x4){hi[0], hi[1], hi[2], hi[3]}; *(f32x4*)(o + 36) = (f32x4){hi[4], hi[5], hi[6], hi[7]};
                        unsigned short* p = KIB + (size_t)krow * 64 + fq * 8;
                        v4u w; w.x = pkh(lo[0], lo[1]); w.y = pkh(lo[2], lo[3]); w.z = pkh(lo[4], lo[5]); w.w = pkh(lo[6], lo[7]); *(v4u*)p = w;
                        w.x = pkh(hi[0], hi[1]); w.y = pkh(hi[2], hi[3]); w.z = pkh(hi[4], hi[5]); w.w = pkh(hi[6], hi[7]); *(v4u*)(p + 32) = w;
                    }
                } else if (pn == 4) {
                    const int vc = (wc - 2) * 32 + fq * 8;
                    float* o = out + (smp ? O_VS + (size_t)(row - NPR) * 128 : O_VP + (size_t)row * 128) + vc;
                    *(f32x4*)o = (f32x4){lo[0], lo[1], lo[2], lo[3]}; *(f32x4*)(o + 4) = (f32x4){lo[4], lo[5], lo[6], lo[7]};
                    *(f32x4*)(o + 64) = (f32x4){hi[0], hi[1], hi[2], hi[3]}; *(f32x4*)(o + 68) = (f32x4){hi[4], hi[5], hi[6], hi[7]};
                    bf16* p = VB + (size_t)krow * 128 + vc;
                    v4u w; w.x = cvt_pk_bf16(lo[0], lo[1]); w.y = cvt_pk_bf16(lo[2], lo[3]); w.z = cvt_pk_bf16(lo[4], lo[5]); w.w = cvt_pk_bf16(lo[6], lo[7]); *(v4u*)p = w;
                    w.x = cvt_pk_bf16(hi[0], hi[1]); w.y = cvt_pk_bf16(hi[2], hi[3]); w.z = cvt_pk_bf16(hi[4], hi[5]); w.w = cvt_pk_bf16(hi[6], hi[7]); *(v4u*)(p + 64) = w;
                } else if (pn == 5) {
                    if (wc == 1 && fq == 0) {
                        const float sc = 0.35355339059327373f;
                        float* o = WI + (size_t)row * 8;
                        *(f32x4*)o = (f32x4){lo[0] * sc, lo[1] * sc, lo[2] * sc, lo[3] * sc}; *(f32x4*)(o + 4) = (f32x4){lo[4] * sc, lo[5] * sc, lo[6] * sc, lo[7] * sc};
                    }
                } else if (pn < 10) {
                    const int ch = (pn - 6) * 128 + wc * 32 + fq * 8;
                    float cv[8];
#pragma unroll
                    for (int i = 0; i < 8; ++i) cv[i] = lo[i] * sigmoidf_(hi[i]);
                    v4u w; w.x = cvt_pk_bf16(cv[0], cv[1]); w.y = cvt_pk_bf16(cv[2], cv[3]); w.z = cvt_pk_bf16(cv[4], cv[5]); w.w = cvt_pk_bf16(cv[6], cv[7]);
                    *(v4u*)(C + (size_t)row * DFF + ch) = w;
                    if (!smp && (row & 255) >= 226 && ((row >> 8) & 31) != 31) { const int p = row >> 8;
                        *(v4u*)((bf16*)(wsb + ((p >> 5) ? WS_HALO_B : WS_HALO_A)) + (size_t)((p & 31) * 30 + (row & 255) - 226) * 512 + ch) = w; }
                    int crow = -1; size_t cb = 0;
                    if (smp) { if (sj >= 34) { crow = sb * 30 + sj - 34; cb = O_CS; } }
                    else { const int b = row >> 13; if (pos >= TPR - 30) { crow = b * 30 + pos - (TPR - 30); cb = O_CP; } }
                    if (crow >= 0) { float* o = out + cb + (size_t)crow * 512 + ch;
                        *(f32x4*)o = (f32x4){cv[0], cv[1], cv[2], cv[3]}; *(f32x4*)(o + 4) = (f32x4){cv[4], cv[5], cv[6], cv[7]}; }
                } else {
                    const int col = (pn - 10) * 256 + wc * 32 + fq * 8;
                    const f32x4 b0 = gb0, b1 = gb1, b2 = gb2, b3 = gb3;
                    v4u w; w.x = cvt_pk_bf16(sigmoidf_(lo[0] + b0.x), sigmoidf_(lo[1] + b0.y)); w.y = cvt_pk_bf16(sigmoidf_(lo[2] + b0.z), sigmoidf_(lo[3] + b0.w));
                    w.z = cvt_pk_bf16(sigmoidf_(lo[4] + b1.x), sigmoidf_(lo[5] + b1.y)); w.w = cvt_pk_bf16(sigmoidf_(lo[6] + b1.z), sigmoidf_(lo[7] + b1.w));
                    *(v4u*)(G + (size_t)row * DFF + col) = w;
                    w.x = cvt_pk_bf16(sigmoidf_(hi[0] + b2.x), sigmoidf_(hi[1] + b2.y)); w.y = cvt_pk_bf16(sigmoidf_(hi[2] + b2.z), sigmoidf_(hi[3] + b2.w));
                    w.z = cvt_pk_bf16(sigmoidf_(hi[4] + b3.x), sigmoidf_(hi[5] + b3.y)); w.w = cvt_pk_bf16(sigmoidf_(hi[6] + b3.z), sigmoidf_(hi[7] + b3.w));
                    *(v4u*)(G + (size_t)row * DFF + col + 128) = w;
                }
                asm volatile("" ::: "memory");
            }
    }
};

struct EpiMerge {
    static constexpr bool PERM = true, AFTER_DRAIN = false;
    const bf16* G; bf16* MG;
    __device__ __forceinline__ void operator()(const f32x4 (&acc)[2][2][4][2], const pg8::Unit& u, int wr, int wc, int fr, int fq) const {
        asm volatile("" : "+v"(fr), "+v"(fq));
#pragma unroll
        for (int ai = 0; ai < 2; ++ai)
#pragma unroll
            for (int m = 0; m < 4; ++m) {
                const int row = u.pm * 256 + ai * 128 + wr * 64 + m * 16 + fr;
#pragma unroll
                for (int bj = 0; bj < 2; ++bj) {
                    const int col = u.pn * 256 + bj * 128 + wc * 32 + fq * 8;
                    const v4u g = *(const v4u*)(G + (size_t)row * DFF + (u.z ? 1024 : 0) + col);
                    float o[8];
                    o[0] = bflo(g.x) * acc[ai][bj][m][0].x; o[1] = bfhi(g.x) * acc[ai][bj][m][0].y; o[2] = bflo(g.y) * acc[ai][bj][m][0].z; o[3] = bfhi(g.y) * acc[ai][bj][m][0].w;
                    o[4] = bflo(g.z) * acc[ai][bj][m][1].x; o[5] = bfhi(g.z) * acc[ai][bj][m][1].y; o[6] = bflo(g.w) * acc[ai][bj][m][1].z; o[7] = bfhi(g.w) * acc[ai][bj][m][1].w;
                    bf16* p = MG + (size_t)row * DM + col;
                    if (u.z) { const v4u t = *(const v4u*)p;
                        o[0] += bflo(t.x); o[1] += bfhi(t.x); o[2] += bflo(t.y); o[3] += bfhi(t.y); o[4] += bflo(t.z); o[5] += bfhi(t.z); o[6] += bflo(t.w); o[7] += bfhi(t.w); }
                    v4u w; w.x = cvt_pk_bf16(o[0], o[1]); w.y = cvt_pk_bf16(o[2], o[3]); w.z = cvt_pk_bf16(o[4], o[5]); w.w = cvt_pk_bf16(o[6], o[7]);
                    *(v4u*)p = w;
                }
            }
    }
};

struct TpItem { const float* W; const float* gain; bf16* WT; int N, src0, nvalid, K, dst0, k0; };
__device__ __forceinline__ void tp_load(const TpItem& t, f32x4 (&nv)[8], int lane) {
#pragma unroll
    for (int i = 0; i < 8; ++i) { const int kk = 8 * i + (lane >> 3), n4 = (lane & 7) * 4;
        f32x4 v = (n4 < t.nvalid) ? *(const f32x4*)(t.W + (size_t)(t.k0 + kk) * t.N + t.src0 + n4) : (f32x4){0.f, 0.f, 0.f, 0.f};
        if (t.gain) v = v * t.gain[t.k0 + kk];
        nv[i] = v; }
}
__device__ __forceinline__ void tp_finish(const TpItem& t, const f32x4 (&nv)[8], LAS float* scr, int lane) {
#pragma unroll
    for (int i = 0; i < 8; ++i) { const int kk = 8 * i + (lane >> 3), n4 = (lane & 7) * 4; LAS float* d = scr + kk * 33 + n4; d[0] = nv[i].x; d[1] = nv[i].y; d[2] = nv[i].z; d[3] = nv[i].w; }
    LDS_WAIT(); asm volatile("" ::: "memory");
    const int c = lane & 7;
#pragma unroll
    for (int j = 0; j < 4; ++j) { const int n = (lane >> 3) + 8 * j; const LAS float* sp = scr + (8 * c) * 33 + n;
        v4u o; o.x = pk2(sp[0 * 33], sp[1 * 33]); o.y = pk2(sp[2 * 33], sp[3 * 33]); o.z = pk2(sp[4 * 33], sp[5 * 33]); o.w = pk2(sp[6 * 33], sp[7 * 33]);
        *(v4u*)(t.WT + (size_t)(t.dst0 + n) * t.K + t.k0 + 8 * c) = o; }
    LDS_WAIT(); asm volatile("" ::: "memory");
}
__device__ __forceinline__ int map_swiglu(int R) { const int pn = R >> 8, r = R & 255; return r < 128 ? 128 * pn + r : DFF + 128 * pn + (r - 128); }
__device__ __forceinline__ void map_win(int R, int& src, int& nv) {
    const int t = R >> 8, r = R & 255; nv = 32;
    if (t < 4) { const int base = t < 2 ? 0 : 768, tt = t & 1; src = r < 128 ? base + (4 * tt + (r >> 5)) * 64 : base + (4 * tt + ((r - 128) >> 5)) * 64 + 32; }
    else if (t == 4) { if (r < 64) src = 512 + (r >> 5) * 64; else if (r < 128) src = 640 + (r - 64); else if (r < 192) src = 512 + ((r - 128) >> 5) * 64 + 32; else src = 704 + (r - 192); }
    else if (t == 5) { if (r == 0) src = 1280; else if (r == 32) { src = 1344; nv = 8; } else if (r == 128) src = 1312; else { src = 0; nv = 0; } }
    else if (t < 10) { const int tt = t - 6; src = r < 128 ? 1352 + 128 * tt + r : 1864 + 128 * tt + (r - 128); }
    else src = 2376 + 256 * (t - 10) + r;
}
__device__ __forceinline__ void sincos_tab(double a, float& c, float& s) {
    const double k = rint(a * 0.63661977236758134308);
    double r = fma(-k, 1.57079632679489655800e+00, a); r = fma(-k, 6.12323399573676603587e-17, r);
    const int q = (int)k & 3; const double r2 = r * r;
    double sp = 1.0 / 6227020800.0; sp = sp * r2 - 1.0 / 39916800.0; sp = sp * r2 + 1.0 / 362880.0; sp = sp * r2 - 1.0 / 5040.0; sp = sp * r2 + 1.0 / 120.0; sp = sp * r2 - 1.0 / 6.0; sp = sp * r2 + 1.0; sp = sp * r;
    double cp = -1.0 / 87178291200.0; cp = cp * r2 + 1.0 / 479001600.0; cp = cp * r2 - 1.0 / 3628800.0; cp = cp * r2 + 1.0 / 40320.0; cp = cp * r2 - 1.0 / 720.0; cp = cp * r2 + 1.0 / 24.0; cp = cp * r2 - 0.5; cp = cp * r2 + 1.0;
    const double cc = (q == 0) ? cp : (q == 1) ? -sp : (q == 2) ? -cp : sp;
    const double ss = (q == 0) ? sp : (q == 1) ? cp : (q == 2) ? -sp : -cp;
    c = (float)cc; s = (float)ss;
}

template <int NK> __device__ __forceinline__ float topk_rebuild(LAS float* val, LAS unsigned short* idx, LAS unsigned* hist, int c, int lane, float tau_prev) {
    unsigned hi[NK], lo[NK]; unsigned alive = 0u, sel = 0u;
#pragma unroll
    for (int k = 0; k < NK; ++k) { const int e = lane + 64 * k; const bool ok = e < c;
        const unsigned fv = __float_as_uint(val[e]); const unsigned iv = (unsigned)idx[e];
        const unsigned uu = (fv & 0x80000000u) ? ~fv : (fv | 0x80000000u);
        hi[k] = ok ? uu : 0u; lo[k] = ok ? (0xFFFFu - iv) : 0u; alive |= ok ? (1u << k) : 0u; }
    unsigned mxk = 0u;
#pragma unroll
    for (int k = 0; k < NK; ++k) mxk = hi[k] > mxk ? hi[k] : mxk;
#pragma unroll
    for (int o = 1; o < 64; o <<= 1) { const unsigned t = (unsigned)__shfl_xor((int)mxk, o); mxk = t > mxk ? t : mxk; }
    const unsigned tb = __float_as_uint(tau_prev), lk = (tb & 0x80000000u) ? ~tb : (tb | 0x80000000u), df = mxk ^ lk;
    const int hb = df ? 31 - __builtin_clz(df) : -1;
    unsigned P_hi = hb >= 31 ? 0u : (hb < 0 ? mxk : (mxk & ~((2u << hb) - 1u))), P_lo = 0u; bool done = false;
#pragma unroll 1
    for (int b = hb; b >= 0; --b) {
        const unsigned trial = P_hi | (1u << b); int c = 0;
#pragma unroll
        for (int k = 0; k < NK; ++k) { c += __builtin_popcountll(__builtin_amdgcn_ballot_w64(hi[k] >= trial)); asm volatile("" : "+s"(c)); }
        if (c >= 256) { P_hi = trial; if (c == 256) { done = true; break; } }
    }
    if (!done) {
        int cgt = 0;
#pragma unroll
        for (int k = 0; k < NK; ++k) { cgt += __builtin_popcountll(__builtin_amdgcn_ballot_w64(hi[k] > P_hi)); asm volatile("" : "+s"(cgt)); }
#pragma unroll 1
        for (int b = 15; b >= 0; --b) {
            const unsigned trial = P_lo | (1u << b); int c = cgt;
#pragma unroll
            for (int k = 0; k < NK; ++k) { c += __builtin_popcountll(__builtin_amdgcn_ballot_w64(hi[k] == P_hi && lo[k] >= trial)); asm volatile("" : "+s"(c)); }
            if (c >= 256) { P_lo = trial; if (c == 256) break; }
        }
    }
#pragma unroll
    for (int k = 0; k < NK; ++k) if (((alive >> k) & 1u) && (hi[k] > P_hi || (hi[k] == P_hi && lo[k] >= P_lo))) sel |= 1u << k;
    unsigned mn = 0xFFFFFFFFu;
#pragma unroll
    for (int k = 0; k < NK; ++k) if ((sel >> k) & 1u) mn = hi[k] < mn ? hi[k] : mn;
#pragma unroll
    for (int o = 1; o < 64; o <<= 1) { const unsigned t = (unsigned)__shfl_xor((int)mn, o); mn = t < mn ? t : mn; }
    int base = 0;
#pragma unroll
    for (int k = 0; k < NK; ++k) { const bool b = (sel >> k) & 1u; const unsigned long long bm = __ballot(b);
        if (b) { const int pos = base + __popcll(bm & ((1ull << lane) - 1ull)); const unsigned uu = hi[k];
            val[pos] = __uint_as_float((uu & 0x80000000u) ? (uu & 0x7FFFFFFFu) : ~uu); idx[pos] = (unsigned short)(0xFFFFu - lo[k]); }
        base += __popcll(bm); }
    return __uint_as_float((mn & 0x80000000u) ? (mn & 0x7FFFFFFFu) : ~mn);
}

__device__ __forceinline__ void attn_query(int tok, int nsel, int keybase, const LAS unsigned short* sidx, LAS float* P, LAS float* INV,
                                           const bf16* Qp, const bf16* KBp, const bf16* VBp, bf16* AOp, int lane) {
    asm volatile("" : "+v"(lane));
    const int q16 = lane & 15, g4 = lane >> 4;
    bf16x8 Bq[2][2];
#pragma unroll
    for (int c = 0; c < 2; ++c)
#pragma unroll
        for (int ks = 0; ks < 2; ++ks) {
            bf16x8 z = {0, 0, 0, 0, 0, 0, 0, 0};
            if (q16 < 8 && (q16 >> 2) == c) z = *(const bf16x8*)(Qp + (size_t)tok * 512 + q16 * 64 + ks * 32 + g4 * 8);
            Bq[c][ks] = z;
        }
    float mx = -INFINITY;
#define QK_LOAD(DST, G) do { _Pragma("unroll") for (int u_ = 0; u_ < 2; ++u_) { const int slot_ = 32 * (G) + 16 * u_ + q16; const int kidx_ = slot_ < nsel ? (int)sidx[slot_] : 0; \
        const bf16* kp_ = KBp + (size_t)(keybase + kidx_) * 128 + g4 * 8; \
        DST[u_][0] = *(const bf16x8*)kp_; DST[u_][1] = *(const bf16x8*)(kp_ + 32); DST[u_][2] = *(const bf16x8*)(kp_ + 64); DST[u_][3] = *(const bf16x8*)(kp_ + 96); } } while (0)
#define QK_MMA(SRC, G) do { _Pragma("unroll") for (int u_ = 0; u_ < 2; ++u_) { const int t_ = 2 * (G) + u_; f32x4 acc_ = {0.f, 0.f, 0.f, 0.f}; \
        acc_ = __builtin_amdgcn_mfma_f32_16x16x32_bf16(SRC[u_][0], Bq[0][0], acc_, 0, 0, 0); acc_ = __builtin_amdgcn_mfma_f32_16x16x32_bf16(SRC[u_][1], Bq[0][1], acc_, 0, 0, 0); \
        acc_ = __builtin_amdgcn_mfma_f32_16x16x32_bf16(SRC[u_][2], Bq[1][0], acc_, 0, 0, 0); acc_ = __builtin_amdgcn_mfma_f32_16x16x32_bf16(SRC[u_][3], Bq[1][1], acc_, 0, 0, 0); \
        _Pragma("unroll") for (int j_ = 0; j_ < 4; ++j_) { const int sl_ = 16 * t_ + 4 * g4 + j_; const float v_ = sl_ < nsel ? acc_[j_] * 0.125f : -INFINITY; mx = fmaxf(mx, v_); if (q16 < 8) P[sl_ * 8 + q16] = v_; } } } while (0)
    {
        bf16x8 ka[2][4], kb[2][4];
        QK_LOAD(ka, 0);
#pragma unroll 1
        for (int g = 0; g < 8; g += 2) {
            QK_LOAD(kb, g + 1); QK_MMA(ka, g);
            if (g + 2 < 8) QK_LOAD(ka, g + 2);
            QK_MMA(kb, g + 1);
        }
    }
    mx = fmaxf(mx, __shfl_xor(mx, 16)); mx = fmaxf(mx, __shfl_xor(mx, 32));
    LDS_WAIT(); asm volatile("" ::: "memory");
    float sum = 0.f;
    if (q16 < 8) {
#pragma unroll 4
        for (int t = 0; t < 16; ++t)
#pragma unroll
            for (int j = 0; j < 4; ++j) { const int sl = 16 * t + 4 * g4 + j; const float e = __expf(P[sl * 8 + q16] - mx); P[sl * 8 + q16] = e; sum += e; }
    }
    sum += __shfl_xor(sum, 16); sum += __shfl_xor(sum, 32);
    if (lane < 8) INV[lane] = 1.0f / sum;
    LDS_WAIT(); asm volatile("" ::: "memory");
    const int ks = lane >> 4, sg = lane & 15, c = sg >> 3, d0 = (sg & 7) * 8;
    float o[4][8];
#pragma unroll
    for (int h = 0; h < 4; ++h)
#pragma unroll
        for (int d = 0; d < 8; ++d) o[h][d] = 0.f;
    const bf16* vbase = VBp + (size_t)keybase * 128 + c * 64 + d0;
#define PV_LOAD(DST, S0) do { const int sb_ = (S0) + 8 * ks; v4u i8_ = *(const LAS v4u*)(sidx + sb_); if (sb_ >= nsel) i8_ = (v4u){0u, 0u, 0u, 0u}; \
        const unsigned ix_[8] = {i8_.x & 0xffffu, i8_.x >> 16, i8_.y & 0xffffu, i8_.y >> 16, i8_.z & 0xffffu, i8_.z >> 16, i8_.w & 0xffffu, i8_.w >> 16}; \
        _Pragma("unroll") for (int i_ = 0; i_ < 8; ++i_) DST[i_] = *(const v4u*)(vbase + (size_t)ix_[i_] * 128); } while (0)
#define PV_FMA(SRC, S0) do { const int sb_ = (S0) + 8 * ks; \
        _Pragma("unroll") for (int i_ = 0; i_ < 8; ++i_) { const f32x4 p_ = *(const LAS f32x4*)(P + (sb_ + i_) * 8 + 4 * c); \
            const float x_[8] = {bflo(SRC[i_].x), bfhi(SRC[i_].x), bflo(SRC[i_].y), bfhi(SRC[i_].y), bflo(SRC[i_].z), bfhi(SRC[i_].z), bflo(SRC[i_].w), bfhi(SRC[i_].w)}; \
            _Pragma("unroll") for (int h_ = 0; h_ < 4; ++h_) _Pragma("unroll") for (int d_ = 0; d_ < 8; ++d_) o[h_][d_] += p_[h_] * x_[d_]; \
            if ((i_ & 3) == 3) asm volatile("" ::: "memory"); } } while (0)
    {
        v4u va[8], vb[8];
        PV_LOAD(va, 0);
#pragma unroll 1
        for (int s0 = 0; s0 < 256; s0 += 64) {
            PV_LOAD(vb, s0 + 32); PV_FMA(va, s0);
            if (s0 + 64 < 256) PV_LOAD(va, s0 + 64);
            PV_FMA(vb, s0 + 32);
        }
    }
#pragma unroll
    for (int h = 0; h < 4; ++h)
#pragma unroll
        for (int d = 0; d < 8; ++d) { float t = o[h][d]; t += __shfl_xor(t, 16); t += __shfl_xor(t, 32); o[h][d] = t; }
    if (ks == 0) {
        const f32x4 iv = *(const LAS f32x4*)(INV + 4 * c);
#pragma unroll
        for (int h = 0; h < 4; ++h) { v4u w; w.x = cvt_pk_bf16(o[h][0] * iv[h], o[h][1] * iv[h]); w.y = cvt_pk_bf16(o[h][2] * iv[h], o[h][3] * iv[h]);
            w.z = cvt_pk_bf16(o[h][4] * iv[h], o[h][5] * iv[h]); w.w = cvt_pk_bf16(o[h][6] * iv[h], o[h][7] * iv[h]);
            *(v4u*)(AOp + (size_t)tok * 512 + (4 * c + h) * 64 + d0) = w; }
    }
    LDS_WAIT(); asm volatile("" ::: "memory");
}

#define XB_TMO      128
#define XB_XCNT(j)  (256  + 64 * (j))
#define XB_XSUB(j)  (1280 + 64 * (j))
#define XB_XGEN(j)  (2304 + 64 * (j))
#define XB_TOP      3328
#define XB_TOPGEN   3392
#define XCD_BAR_WORDS 3456
#define XB_SPIN_CAP (1u << 18)

__device__ __forceinline__ unsigned xb_ld(unsigned* p)              { return __hip_atomic_load(p, __ATOMIC_RELAXED, __HIP_MEMORY_SCOPE_AGENT); }
__device__ __forceinline__ unsigned xb_add(unsigned* p, unsigned v) { return __hip_atomic_fetch_add(p, v, __ATOMIC_RELAXED, __HIP_MEMORY_SCOPE_AGENT); }
__device__ __forceinline__ unsigned xb_xcc_id() { return (unsigned)__builtin_amdgcn_s_getreg((3 << 11) | 20) & 0xFu; }
#define XB_SPIN(cond, bar) do { unsigned _sp = 0; while (cond) { __builtin_amdgcn_s_sleep(1); \
    if ((++_sp & 255u) == 0u) { if (xb_ld(&(bar)[XB_TMO])) break; if (_sp > XB_SPIN_CAP) { atomicAdd(&(bar)[XB_TMO], 1u); break; } } } } while (0)

struct XcdBarrier {
    unsigned* bar; unsigned x;
    volatile LAS unsigned* st;
};

__device__ __forceinline__ XcdBarrier xcd_barrier_post(unsigned* bar, volatile LAS unsigned* st) {
    XcdBarrier b; b.bar = bar; b.x = xb_xcc_id(); b.st = st;
    if (threadIdx.x == 0) (void)xb_add(&bar[XB_XCNT(b.x)], 1u);
    return b;
}
__device__ __forceinline__ void xcd_barrier_complete(unsigned* bar, unsigned x, unsigned& nloc, unsigned& nx) {
    const unsigned G = gridDim.x * gridDim.y * gridDim.z;
    unsigned sum, cnt, mine, sp = 0u;
    for (;;) {
        sum = 0u; cnt = 0u; mine = 0u;
#pragma unroll
        for (unsigned j = 0; j < 16; ++j) { const unsigned c = xb_ld(&bar[XB_XCNT(j)]); sum += c; cnt += (c > 0u) ? 1u : 0u; mine = (j == x) ? c : mine; }
        if (sum == G) break;
        __builtin_amdgcn_s_sleep(1);
        if ((++sp & 255u) == 0u) { if (xb_ld(&bar[XB_TMO])) break; if (sp > XB_SPIN_CAP) { atomicAdd(&bar[XB_TMO], 1u); break; } }
    }
    nloc = mine > 0u ? mine : 1u; nx = cnt > 0u ? cnt : 1u;
}

__device__ __forceinline__ void xcd_barrier(const XcdBarrier& b) {
    asm volatile("s_waitcnt vmcnt(0)" ::: "memory");
    __syncthreads();
    if (threadIdx.x == 0) {
        unsigned* bar = b.bar;
        __builtin_amdgcn_s_waitcnt(0);
        unsigned nloc = b.st[0], nx = b.st[1];
        if (nloc == 0u) { xcd_barrier_complete(bar, b.x, nloc, nx); b.st[0] = nloc; b.st[1] = nx; }
        const unsigned old = xb_add(&bar[XB_XSUB(b.x)], 1u);
        const unsigned gen = old / nloc;
        if (old + 1u == (gen + 1u) * nloc) {
            __builtin_amdgcn_fence(__ATOMIC_RELEASE, "agent");
            asm volatile("s_waitcnt vmcnt(0)" ::: "memory");
            const unsigned og = xb_add(&bar[XB_TOP], 1u);
            const unsigned tg = og / nx;
            if (og + 1u == (tg + 1u) * nx) xb_add(&bar[XB_TOPGEN], 1u);
            else XB_SPIN(xb_ld(&bar[XB_TOPGEN]) == tg, bar);
            __builtin_amdgcn_fence(__ATOMIC_ACQUIRE, "agent");
            xb_add(&bar[XB_XGEN(b.x)], 1u);
            asm volatile("s_waitcnt vmcnt(0)" ::: "memory");
        } else {
            XB_SPIN(xb_ld(&bar[XB_XGEN(b.x)]) == gen, bar);
            __builtin_amdgcn_fence(__ATOMIC_ACQUIRE, "agent");
            asm volatile("s_waitcnt vmcnt(0)" ::: "memory");
        }
    }
    __syncthreads();
}

#ifdef TSEL
#define TSTAMP() do { if (bx == 0 && tid == 0) { ((volatile LAS unsigned long long*)(lds + 131072 + 1024))[ts_n] = __builtin_amdgcn_s_memrealtime(); } ++ts_n; } while (0)
#else
#define TSTAMP() do {} while (0)
#endif
#define LBAR() do { asm volatile("s_waitcnt lgkmcnt(0)" ::: "memory"); __builtin_amdgcn_s_barrier(); asm volatile("" ::: "memory"); } while (0)
#define GSYNC() do { grid.sync(); TSTAMP(); } while (0)
#define XSYNC() do { xcd_barrier(xbar); TSTAMP(); } while (0)
#define LSYNC() do { asm volatile("s_waitcnt vmcnt(0)" ::: "memory"); __syncthreads(); ++ls_ep; \
    if (tid == 0) { unsigned* cp_ = CTL + 5120 + 64 * xcc; __hip_atomic_fetch_add(cp_, 1u, __ATOMIC_RELAXED, __HIP_MEMORY_SCOPE_AGENT); \
        const unsigned want_ = (unsigned)ls_ep * (unsigned)x_nloc; unsigned sp_ = 0u; \
        while (__hip_atomic_load(cp_, __ATOMIC_RELAXED, __HIP_MEMORY_SCOPE_AGENT) < want_) { __builtin_amdgcn_s_sleep(2); if (++sp_ > (1u << 22)) break; } \
        __builtin_amdgcn_fence(__ATOMIC_ACQUIRE, "agent"); asm volatile("s_waitcnt vmcnt(0)" ::: "memory"); } \
    __syncthreads(); TSTAMP(); } while (0)
#ifndef PHMASK
#define PHMASK 0x3ff
#endif
__global__ void __launch_bounds__(512, 2) mega_fwd(Args args) {
    extern __shared__ __attribute__((aligned(16))) unsigned char lds_raw[];
    cg::grid_group grid = cg::this_grid();
    LAS unsigned char* lds = (LAS unsigned char*)lds_raw;
    const int tid = threadIdx.x, lane = tid & 63, wave = __builtin_amdgcn_readfirstlane(tid >> 6);
    const int G = gridDim.x, bx = blockIdx.x;
    const int gw = bx * NWAVES + wave, NGW = G * NWAVES;
    volatile LAS int* XW = (volatile LAS int*)(lds + 131072 + 64);
    const unsigned xcc = (unsigned)__builtin_amdgcn_s_getreg((3 << 11) | 20) & 0xFu;
    int ts_n = 0; TSTAMP();
    if (tid < 2) XW[56 + tid] = 0;
    __syncthreads();
    grid.sync();
    const XcdBarrier xbar = xcd_barrier_post((unsigned*)(args.ws + WS_CTL) + 12288, (volatile LAS unsigned*)(lds + 131072 + 64 + 56 * 4));
    int ls_ep = 0;
#ifdef P4PROBE
    if (tid == 0) { volatile LAS unsigned long long* TS = (volatile LAS unsigned long long*)(lds + 131072 + 1024); TS[40] = 0; TS[41] = 0; TS[42] = 0; TS[43] = 0; }
#endif
    if (tid == 0) XW[0] = (int)__hip_atomic_fetch_add((unsigned*)(args.ws + WS_CTL) + 1024 + 64 * xcc, 1u, __ATOMIC_RELAXED, __HIP_MEMORY_SCOPE_AGENT);
#define ws (args.ws)
#define out (args.out)
#define xP (args.in[0])
#define xS (args.in[1])
#define W1T ((bf16*)(ws + WS_W1T))
#define W1OT ((bf16*)(ws + WS_W1OT))
#define WINT ((bf16*)(ws + WS_WINT))
#define WCOT ((bf16*)(ws + WS_WCOT))
#define WAOT ((bf16*)(ws + WS_WAOT))
#define WOT ((bf16*)(ws + WS_WOT))
#define W2T ((bf16*)(ws + WS_W2T))
#define W2OT ((bf16*)(ws + WS_W2OT))
#define XB ((bf16*)(ws + WS_XB))
#define ACT ((bf16*)(ws + WS_ACT))
#define GATE ((bf16*)(ws + WS_GATE))
#define CB ((bf16*)(ws + WS_ACT) + 2048)
#define QB ((bf16*)(ws + WS_Q))
#define QIB ((unsigned short*)(ws + WS_QI))
#define MG ((bf16*)(ws + WS_MERGED))
#define KB ((bf16*)(ws + WS_KB))
#define VB ((bf16*)(ws + WS_VB))
#define KIB ((unsigned short*)(ws + WS_KIB))
#define AO ((bf16*)(ws + WS_AO))
#define CA ((bf16*)(ws + WS_CA))
#define RSTD0 ((float*)(ws + WS_RSTD0))
#define WI ((float*)(ws + WS_WI))
#define SSQ1 ((float*)(ws + WS_SSQ1))
#define SSQ2 ((float*)(ws + WS_SSQ2))
#define SSQ3 ((float*)(ws + WS_SSQ3))
#define COST ((float*)(ws + WS_COS))
#define SINT ((float*)(ws + WS_SIN))
#define CTL ((unsigned*)(ws + WS_CTL))
#define H (out + O_Y)

    if (PHMASK & (1 << 0)) {
        LAS float* scr = (LAS float*)(lds + wave * 16384);
        if (bx == 0 && tid < 16) { CTL[2048 + 64 * tid] = 0u; CTL[3072 + 64 * tid] = 0u; }
        constexpr int I_W1 = 16 * 176, I_W1O = 44 * 32, I_WIN = 16 * 144, I_WCO = 8 * 32, I_WAO = 8 * 32, I_WO = 16 * 32, I_W2 = I_W1, I_W2O = I_W1O;
        constexpr int NIT = I_W1 + I_W1O + I_WIN + I_WCO + I_WAO + I_WO + I_W2 + I_W2O;
#define TP_DECODE(IT, T) do { int r_ = (IT); \
        if (r_ < I_W1) { const int kb_ = r_ / 176, g_ = r_ % 176; T.W = args.in[7]; T.N = 2 * DFF; T.src0 = map_swiglu(32 * g_); T.nvalid = 32; T.gain = args.in[6]; T.WT = W1T; T.K = 1024; T.dst0 = 32 * g_; T.k0 = 64 * kb_; break; } r_ -= I_W1; \
        if (r_ < I_W1O) { const int kb_ = r_ / 32, g_ = r_ % 32; T.W = args.in[8]; T.N = 1024; T.src0 = 32 * g_; T.nvalid = 32; T.gain = nullptr; T.WT = W1OT; T.K = DFF; T.dst0 = 32 * g_; T.k0 = 64 * kb_; break; } r_ -= I_W1O; \
        if (r_ < I_WIN) { const int kb_ = r_ / 144, g_ = r_ % 144; int src_, nv_; map_win(32 * g_, src_, nv_); T.W = args.in[10]; T.N = 4424; T.src0 = src_; T.nvalid = nv_; T.gain = args.in[9]; T.WT = WINT; T.K = 1024; T.dst0 = 32 * g_; T.k0 = 64 * kb_; break; } r_ -= I_WIN; \
        if (r_ < I_WCO) { const int kb_ = r_ / 32, g_ = r_ % 32; T.W = args.in[16]; T.N = 1024; T.src0 = 32 * g_; T.nvalid = 32; T.gain = nullptr; T.WT = WCOT; T.K = 512; T.dst0 = 32 * g_; T.k0 = 64 * kb_; break; } r_ -= I_WCO; \
        if (r_ < I_WAO) { const int kb_ = r_ / 32, g_ = r_ % 32; T.W = args.in[17]; T.N = 1024; T.src0 = 32 * g_; T.nvalid = 32; T.gain = nullptr; T.WT = WAOT; T.K = 512; T.dst0 = 32 * g_; T.k0 = 64 * kb_; break; } r_ -= I_WAO; \
        if (r_ < I_WO) { const int kb_ = r_ / 32, g_ = r_ % 32; T.W = args.in[18]; T.N = 1024; T.src0 = 32 * g_; T.nvalid = 32; T.gain = nullptr; T.WT = WOT; T.K = 1024; T.dst0 = 32 * g_; T.k0 = 64 * kb_; break; } r_ -= I_WO; \
        if (r_ < I_W2) { const int kb_ = r_ / 176, g_ = r_ % 176; T.W = args.in[20]; T.N = 2 * DFF; T.src0 = map_swiglu(32 * g_); T.nvalid = 32; T.gain = args.in[19]; T.WT = W2T; T.K = 1024; T.dst0 = 32 * g_; T.k0 = 64 * kb_; break; } r_ -= I_W2; \
        { const int kb_ = r_ / 32, g_ = r_ % 32; T.W = args.in[21]; T.N = 1024; T.src0 = 32 * g_; T.nvalid = 32; T.gain = nullptr; T.WT = W2OT; T.K = DFF; T.dst0 = 32 * g_; T.k0 = 64 * kb_; } } while (0)
        {
            TpItem tc, tn; f32x4 va[8], vb[8];
            int it = gw;
            if (it < NIT) { TP_DECODE(it, tc); tp_load(tc, va, lane); }
            for (; it < NIT; it += NGW) {
                const bool hn = it + NGW < NIT;
                if (hn) { TP_DECODE(it + NGW, tn); tp_load(tn, vb, lane); }
                tp_finish(tc, va, scr, lane);
                if (hn) { tc = tn;
#pragma unroll
                    for (int i = 0; i < 8; ++i) va[i] = vb[i]; }
            }
        }
        for (int row0 = gw; row0 < NTOK; row0 += 3 * NGW) {
            f32x4 v[3][4];
#pragma unroll
            for (int q = 0; q < 3; ++q) { const int row = row0 + q * NGW;
                if (row < NTOK) { const float* xr = row < NPR ? xP + (size_t)row * DM : xS + (size_t)(row - NPR) * DM;
#pragma unroll
                    for (int j = 0; j < 4; ++j) v[q][j] = *(const f32x4*)(xr + 4 * lane + 256 * j); } }
#pragma unroll
            for (int q = 0; q < 3; ++q) { const int row = row0 + q * NGW;
                if (row < NTOK) { float ss = 0.f;
#pragma unroll
                    for (int j = 0; j < 4; ++j) ss += (v[q][j].x * v[q][j].x + v[q][j].y * v[q][j].y) + (v[q][j].z * v[q][j].z + v[q][j].w * v[q][j].w);
                    ss = wave_sum(ss);
                    if (lane == 0) RSTD0[row] = 1.0f / sqrtf(ss * (1.0f / 1024.0f) + EPS);
#pragma unroll
                    for (int j = 0; j < 4; ++j) { v2u w; w.x = pk2(v[q][j].x, v[q][j].y); w.y = pk2(v[q][j].z, v[q][j].w); *(v2u*)(XB + (size_t)row * DM + 4 * lane + 256 * j) = w; } } }
        }
        for (int ch0 = gw; ch0 < 40960; ch0 += 4 * NGW) {
            f32x4 cv[4];
#pragma unroll
            for (int q = 0; q < 4; ++q) { const int ch = ch0 + q * NGW;
                if (ch < 40960) { const float* src = ch < 16384 ? args.in[2] + (size_t)ch * 256 : (ch < 32768 ? args.in[3] + (size_t)(ch - 16384) * 256 : args.in[4] + (size_t)(ch - 32768) * 256);
                    cv[q] = *(const f32x4*)(src + 4 * lane); } }
#pragma unroll
            for (int q = 0; q < 4; ++q) { const int ch = ch0 + q * NGW;
                if (ch < 40960) { const f32x4 v = cv[q];
                    if (ch < 32768) { const bool isv = ch >= 16384; const int e = (isv ? ch - 16384 : ch) * 256 + 4 * lane; const int b = e >> 17, rem = e & 131071;
                        v2u w; w.x = pk2(v.x, v.y); w.y = pk2(v.z, v.w); *(v2u*)((isv ? VB : KB) + (size_t)(NPR + b * LSM) * 128 + rem) = w; }
                    else { const int e = (ch - 32768) * 256 + 4 * lane; const int b = e >> 16, rem = e & 65535;
                        v2u w; w.x = pkh(v.x, v.y); w.y = pkh(v.z, v.w); *(v2u*)(KIB + (size_t)(NPR + b * LSM) * 64 + rem) = w; } } }
        }
        for (int e = bx * 512 + tid; e < TPR * 32; e += G * 512) { float c, s; sincos_tab((double)(e >> 5) * args.invf[e & 31], c, s); COST[e] = c; SINT[e] = s; }
    }
    XSYNC();
    if (tid == 0) {
        int nx = 0, xi = 0, nloc = 1;
        for (int j = 0; j < 16; ++j) { const int c = (int)__hip_atomic_load(CTL + 1024 + 64 * j, __ATOMIC_RELAXED, __HIP_MEMORY_SCOPE_AGENT);
            if (c > 0) { if (j == (int)xcc) { xi = nx; nloc = c; } ++nx; } }
        XW[1] = nx > 0 ? nx : 1; XW[2] = xi; XW[3] = nloc;
    }
    __syncthreads();
    const int x_r = __builtin_amdgcn_readfirstlane(XW[0]), x_nx = __builtin_amdgcn_readfirstlane(XW[1]), x_xi = __builtin_amdgcn_readfirstlane(XW[2]), x_nloc = __builtin_amdgcn_readfirstlane(XW[3]);
    const int x_T = x_nx == 8 ? 9 : (72 - x_xi + x_nx - 1) / x_nx;

    if (PHMASK & (1 << 1)) {
        pg8::Gemm g{XB, W1T, XB, W1T, NTOK, 2 * DFF, 1024}; pg8::XcdOrder S; S.init(NTOK, 2 * DFF, 1024, x_xi, x_nx, x_nloc, x_r, 0, 0);
        EpiSwiglu E{ACT, RSTD0, nullptr};
        pg8::gemm_phase<EpiSwiglu, pg8::XcdOrder, true, true>(lds, g, S, E);
    }
    LSYNC();
    if (PHMASK & (1 << 2)) {
        pg8::Gemm g{ACT, W1OT, ACT, W1OT, NTOK, 1024, DFF}; pg8::XcdOrder S; S.init(NTOK, 1024, DFF, x_xi, x_nx, x_nloc, x_r, 0, 1);
        EpiResid E{xP, xS, H, XB, SSQ1, 0.5f, QB};
        pg8::gemm_phase<EpiResid, pg8::XcdOrder, true, true>(lds, g, S, E);
    }
    LSYNC();
    if (x_nx == 8) {
        for (int jr = x_r * NWAVES + wave; jr < 256; jr += x_nloc * NWAVES) {
            const int row = pg8::xcd_tile(x_xi, x_nx, x_T - 1) * 256 + jr;
            float* hr = H + (size_t)row * DM; f32x4 v[4]; float ss = 0.f;
#pragma unroll
            for (int j = 0; j < 4; ++j) { v[j] = *(const f32x4*)((xS + (size_t)(row - NPR) * DM) + 4 * lane + 256 * j);
                f32x4 sm = {0.f, 0.f, 0.f, 0.f};
#pragma unroll
                for (int c = 0; c < 8; ++c) { const v2u pw = *(const v2u*)(QB + ((size_t)((row >> 8) - 64) * 8 + c) * 256 * DM + (size_t)(row & 255) * DM + 4 * lane + 256 * j);
                    sm.x += bflo(pw.x); sm.y += bfhi(pw.x); sm.z += bflo(pw.y); sm.w += bfhi(pw.y); }
                v[j] = v[j] + sm * 0.5f; *(f32x4*)(hr + 4 * lane + 256 * j) = v[j]; ss += (v[j].x * v[j].x + v[j].y * v[j].y) + (v[j].z * v[j].z + v[j].w * v[j].w); }
            ss = wave_sum(ss);
            if (lane < 16) SSQ1[(size_t)row * 16 + lane] = lane == 0 ? ss : 0.f;
            if (lane == 0) RSTD0[row] = 1.0f / sqrtf(ss * (1.0f / 1024.0f) + EPS);
#pragma unroll
            for (int j = 0; j < 4; ++j) { v2u w; w.x = pk2(v[j].x, v[j].y); w.y = pk2(v[j].z, v[j].w); *(v2u*)(XB + (size_t)row * DM + 4 * lane + 256 * j) = w; }
        }
        for (int jr = (x_r * NWAVES + wave) * 64 + lane; jr < (x_T - 1) * 256; jr += x_nloc * NWAVES * 64) {
            const int row = pg8::xcd_tile(x_xi, x_nx, jr >> 8) * 256 + (jr & 255);
            RSTD0[row] = row_rstd16(SSQ1, row);
        }
        XSYNC();
    }
    else { for (int jr = (x_r * NWAVES + wave) * 64 + lane; jr < x_T * 256; jr += x_nloc * NWAVES * 64) { const int row = pg8::xcd_tile(x_xi, x_nx, jr >> 8) * 256 + (jr & 255); RSTD0[row] = row_rstd16(SSQ1, row); }
        XSYNC(); }
    if (PHMASK & (1 << 3)) {
        pg8::Gemm g{XB, WINT, XB, WINT, NTOK, NIN, 1024}; pg8::XcdOrder S; S.init(NTOK, NIN, 1024, x_xi, x_nx, x_nloc, x_r, 0, 0);
        EpiMix E{RSTD0, COST, SINT, args.in[11], QB, QIB, KB, VB, KIB, WI, CB, GATE, out, ws};
        pg8::gemm_phase<EpiMix, pg8::XcdOrder, true, true>(lds, g, S, E);
    }
    XSYNC();
    if (PHMASK & (1 << 4)) {
        LAS float* cval = (LAS float*)(lds + L_VAL); LAS unsigned short* cidx = (LAS unsigned short*)(lds + L_IDX);
        LAS unsigned* hist = (LAS unsigned*)(lds + L_HIST) + wave * 16;
        volatile LAS unsigned* cnt = (volatile LAS unsigned*)(lds + L_CNT); volatile LAS float* tau = (volatile LAS float*)(lds + L_TAU);
        volatile LAS int* itemw = (volatile LAS int*)(lds + L_ITEM);
        const int q16 = lane & 15, g4 = lane >> 4;
        const int N_ATT = x_T * 16, N_CONV = x_T * 4;
        if (tid == 0) {
            for (int t = 0; t < 16; ++t) { XW[16 + t] = 0; XW[32 + t] = -1; }
            for (int t = 0; t < x_T && t < 16; ++t) { const int pm = pg8::xcd_tile(x_xi, x_nx, t); XW[16 + t] = pm; XW[32 + t] = pm < 64 ? 8 * (pm & 31) + 7 : 33; }
            for (int a = 0; a < 16; ++a) { int best = a; for (int b2 = a + 1; b2 < 16; ++b2) if (XW[32 + b2] > XW[32 + best]) best = b2;
                const int tk = XW[32 + a], tt = XW[16 + a]; XW[32 + a] = XW[32 + best]; XW[16 + a] = XW[16 + best]; XW[32 + best] = tk; XW[16 + best] = tt; }
        }
        for (;;) {
            __syncthreads();
            if (tid == 0) *itemw = (int)atomicAdd(CTL + 2048 + 64 * x_xi, 1u);
            __syncthreads();
            const int item = *itemw;
            if (item >= N_ATT) break;
#ifdef P4PROBE
            const unsigned long long pt0 = __builtin_amdgcn_s_memrealtime();
#endif
            {
                int tok0, N, keybase;
                { const int tile = XW[16 + (item >> 4)], sub = item & 15;
                  if (tile < 64) { const int b = tile >> 5, cl = 3 - (sub >> 2), c = (tile & 31) * 4 + cl, qq = sub & 3; tok0 = tile * 256 + cl * 64 + qq * 16; N = 64 * (c + 1); keybase = b * TPR; }
                  else { tok0 = tile * 256 + sub * 16; const int b = (tok0 - NPR) >> 6; N = LSM; keybase = NPR + b * LSM; } }
                if (N > 256) {
                    if (tid < 16) { cnt[tid] = 0u; tau[tid] = -INFINITY; }
                    if (tid == 0) XW[48] = 0;
                    h16x8 Bq[8][2];
#pragma unroll
                    for (int h = 0; h < 8; ++h)
#pragma unroll
                        for (int ks = 0; ks < 2; ++ks) Bq[h][ks] = *(const h16x8*)(QIB + (size_t)(tok0 + q16) * 512 + h * 64 + ks * 32 + g4 * 8);
                    const f32x4 w0 = *(const f32x4*)(WI + (size_t)(tok0 + q16) * 8), w1 = *(const f32x4*)(WI + (size_t)(tok0 + q16) * 8 + 4);
                    const float wq[8] = {w0.x, w0.y, w0.z, w0.w, w1.x, w1.y, w1.z, w1.w};
                    __syncthreads();
                    const int nrounds = (N + 511) >> 9;
#define LOAD_KI(DST, SEG) do { _Pragma("unroll") for (int t_ = 0; t_ < 4; ++t_) { const unsigned short* kp_ = KIB + (size_t)(keybase + (SEG) + 16 * t_ + q16) * 64 + g4 * 8; \
        DST[t_][0] = *(const h16x8*)kp_; DST[t_][1] = *(const h16x8*)(kp_ + 32); } } while (0)
                    h16x8 An[4][2];
#pragma unroll
                    for (int t = 0; t < 4; ++t) { An[t][0] = (h16x8){0, 0, 0, 0, 0, 0, 0, 0}; An[t][1] = An[t][0]; }
                    if (wave * 64 < N) LOAD_KI(An, wave * 64);
                    for (int r = 0; r < nrounds; ++r) {
#ifdef P4PROBE3
                        const unsigned long long rc0 = __builtin_amdgcn_s_memrealtime();
#endif
                        const int seg = r * 512 + wave * 64;
                        const float tq = tau[q16];
                        if (seg < N) {
#pragma unroll
                            for (int t = 0; t < 4; ++t) {
                                const int key0 = seg + 16 * t;
                                f32x4 sc = {0.f, 0.f, 0.f, 0.f};
#pragma unroll
                                for (int h = 0; h < 8; ++h) {
                                    f32x4 acc = {0.f, 0.f, 0.f, 0.f};
                                    acc = __builtin_amdgcn_mfma_f32_16x16x32_f16(An[t][0], Bq[h][0], acc, 0, 0, 0);
                                    acc = __builtin_amdgcn_mfma_f32_16x16x32_f16(An[t][1], Bq[h][1], acc, 0, 0, 0);
#pragma unroll
                                    for (int j = 0; j < 4; ++j) sc[j] += wq[h] * fmaxf(acc[j], 0.f);
                                }
#pragma unroll
                                for (int j = 0; j < 4; ++j) if (sc[j] > tq) {
                                    const unsigned pos = atomicAdd((unsigned*)(cnt + q16), 1u);
                                    cval[q16 * CAP + pos] = sc[j]; cidx[q16 * CAP + pos] = (unsigned short)(key0 + 4 * g4 + j);
                                }
                            }
                            if (seg + 512 < N) LOAD_KI(An, seg + 512);
                        }
                        LBAR();
#ifdef P4PROBE2
                        const unsigned long long rb0 = __builtin_amdgcn_s_memrealtime();
#endif
                        const bool last = (r == nrounds - 1);
                        bool trig = last;
                        { const volatile LAS v4u* cq = (const volatile LAS v4u*)(lds + L_CNT);
#pragma unroll
                          for (int i4 = 0; i4 < 4; ++i4) { const v4u cc = cq[i4]; trig = trig || cc.x > (unsigned)(CAP - 512) || cc.y > (unsigned)(CAP - 512) || cc.z > (unsigned)(CAP - 512) || cc.w > (unsigned)(CAP - 512); } }
                        if (trig) {
#pragma unroll 1
                            for (int k = 0; k < 2; ++k) { const int qq = 2 * wave + k; const int c = (int)cnt[qq];
                                if (c > 256) { const float t = c <= 512 ? topk_rebuild<8>(cval + qq * CAP, cidx + qq * CAP, hist, c, lane, tau[qq]) : (c <= 1024 ? topk_rebuild<16>(cval + qq * CAP, cidx + qq * CAP, hist, c, lane, tau[qq]) : topk_rebuild<20>(cval + qq * CAP, cidx + qq * CAP, hist, c, lane, tau[qq])); if (lane == 0) { cnt[qq] = 256u; tau[qq] = t; } } }
                        }
                        LBAR();
#ifdef P4PROBE2
                        { const unsigned long long rb1 = __builtin_amdgcn_s_memrealtime(); if (bx == 0 && tid == 0) { volatile LAS unsigned long long* TS = (volatile LAS unsigned long long*)(lds + 131072 + 1024); TS[42] += rb1 - rb0; TS[43] += 1; } }
#endif
                    }
                } else {
                    for (int i = tid; i < 16 * 256; i += 512) cidx[(i >> 8) * CAP + (i & 255)] = (unsigned short)(i & 255);
                    __syncthreads();
                }
                const int nsel = N < 256 ? N : 256;
#ifdef P4PROBE
                const unsigned long long pt1 = __builtin_amdgcn_s_memrealtime();
#endif
#pragma unroll 1
                for (int k = 0; k < 2; ++k) { const int qq = 2 * wave + k;
#ifndef NO_ATTNQ
                    attn_query(tok0 + qq, nsel, keybase, cidx + qq * CAP, (LAS float*)(lds + L_VAL) + wave * 2 * CAP, (LAS float*)hist, QB, KB, VB, AO, lane);
#endif
 }
#ifdef P4PROBE
                __syncthreads(); { const unsigned long long pt2 = __builtin_amdgcn_s_memrealtime(); if (bx == 0 && tid == 0) { volatile LAS unsigned long long* TS = (volatile LAS unsigned long long*)(lds + 131072 + 1024); TS[40] += pt1 - pt0; TS[41] += pt2 - pt1; } }
#endif
            }
        }
        for (;;) {
            __syncthreads();
            if (tid == 0) *itemw = (int)atomicAdd(CTL + 3072 + 64 * x_xi, 1u);
            __syncthreads();
            const int item = *itemw;
            if (item >= N_CONV) break;
            {
                const int tok0 = pg8::xcd_tile(x_xi, x_nx, item >> 2) * 256 + (item & 3) * 64;
                __syncthreads();
                for (int i = tid; i < 31 * 512 / 4; i += 512) ((LAS f32x4*)lds)[i] = ((const f32x4*)args.in[12])[i];
                __syncthreads();
                const int ch = 8 * lane;
                const f32x4 cb0 = *(const f32x4*)(args.in[13] + ch), cb1 = *(const f32x4*)(args.in[13] + ch + 4);
                const f32x4 lg0 = *(const f32x4*)(args.in[14] + ch), lg1 = *(const f32x4*)(args.in[14] + ch + 4);
                const f32x4 lb0 = *(const f32x4*)(args.in[15] + ch), lb1 = *(const f32x4*)(args.in[15] + ch + 4);
                const int t0 = tok0 + wave * 8;
                const bool smp = t0 >= NPR; const int sb = (t0 - NPR) >> 6; const int j0 = smp ? ((t0 - NPR) & 63) : (t0 & (TPR - 1));
                float acc[8][8];
#pragma unroll
                for (int t = 0; t < 8; ++t) { acc[t][0] = cb0.x; acc[t][1] = cb0.y; acc[t][2] = cb0.z; acc[t][3] = cb0.w; acc[t][4] = cb1.x; acc[t][5] = cb1.y; acc[t][6] = cb1.z; acc[t][7] = cb1.w; }
#pragma unroll 2
                for (int rr = 0; rr < 38; ++rr) {
                    const int jr = j0 - 30 + rr;
                    float x[8];
                    if (jr >= 0) { const int st = t0 - 30 + rr; const bf16* xp = CB + (size_t)st * DFF + ch;
                        if ((st >> 8) != (t0 >> 8)) { const int p = st >> 8; xp = (const bf16*)(ws + ((p >> 5) ? WS_HALO_B : WS_HALO_A)) + (size_t)((p & 31) * 30 + (st & 255) - 226) * 512 + ch; }
                        const v4u xv = *(const v4u*)xp;
                        x[0] = bflo(xv.x); x[1] = bfhi(xv.x); x[2] = bflo(xv.y); x[3] = bfhi(xv.y); x[4] = bflo(xv.z); x[5] = bfhi(xv.z); x[6] = bflo(xv.w); x[7] = bfhi(xv.w); }
                    else if (smp) { const float* sp = args.in[5] + (size_t)(sb * 30 + 30 + jr) * 512 + ch; const f32x4 s0 = *(const f32x4*)sp, s1 = *(const f32x4*)(sp + 4);
                        x[0] = s0.x; x[1] = s0.y; x[2] = s0.z; x[3] = s0.w; x[4] = s1.x; x[5] = s1.y; x[6] = s1.z; x[7] = s1.w; }
                    else continue;
#pragma unroll
                    for (int t = 0; t < 8; ++t) { const int w = rr - t;
                        if (w >= 0 && w <= 30) {
                            const f32x4 k0 = *(const LAS f32x4*)(lds + (size_t)(w * 512 + ch) * 4), k1 = *(const LAS f32x4*)(lds + (size_t)(w * 512 + ch + 4) * 4);
                            acc[t][0] += x[0] * k0.x; acc[t][1] += x[1] * k0.y; acc[t][2] += x[2] * k0.z; acc[t][3] += x[3] * k0.w;
                            acc[t][4] += x[4] * k1.x; acc[t][5] += x[5] * k1.y; acc[t][6] += x[6] * k1.z; acc[t][7] += x[7] * k1.w; } }
                }
                const float gg[8] = {lg0.x, lg0.y, lg0.z, lg0.w, lg1.x, lg1.y, lg1.z, lg1.w}, bb[8] = {lb0.x, lb0.y, lb0.z, lb0.w, lb1.x, lb1.y, lb1.z, lb1.w};
#pragma unroll
                for (int t = 0; t < 8; ++t) {
                    float a[8];
#pragma unroll
                    for (int i = 0; i < 8; ++i) a[i] = acc[t][i];
                    float s_ = ((a[0] + a[1]) + (a[2] + a[3])) + ((a[4] + a[5]) + (a[6] + a[7]));
                    const float mean = wave_sum(s_) * (1.0f / 512.0f);
                    float q = 0.f;
#pragma unroll
                    for (int i = 0; i < 8; ++i) { a[i] -= mean; q += a[i] * a[i]; }
                    const float rs = 1.0f / sqrtf(wave_sum(q) * (1.0f / 512.0f) + EPS);
#pragma unroll
                    for (int i = 0; i < 8; ++i) a[i] = siluf_(a[i] * rs * gg[i] + bb[i]);
                    v4u o; o.x = cvt_pk_bf16(a[0], a[1]); o.y = cvt_pk_bf16(a[2], a[3]); o.z = cvt_pk_bf16(a[4], a[5]); o.w = cvt_pk_bf16(a[6], a[7]);
                    *(v4u*)(CA + (size_t)(t0 + t) * 512 + ch) = o;
                }
            }
        }
    }
    XSYNC();
    if (PHMASK & (1 << 5)) {
        pg8::Gemm g{AO, WAOT, CA, WCOT, NTOK, 1024, 512}; pg8::XcdOrder S; S.init(NTOK, 1024, 512, x_xi, x_nx, x_nloc, x_r, 1, 0);
        EpiMerge E{GATE, MG};
        pg8::gemm_phase<EpiMerge, pg8::XcdOrder, true, true>(lds, g, S, E);
    }
    XSYNC();
    if (PHMASK & (1 << 6)) {
        pg8::Gemm g{MG, WOT, MG, WOT, NTOK, 1024, 1024}; pg8::XcdOrder S; S.init(NTOK, 1024, 1024, x_xi, x_nx, x_nloc, x_r, 0, 1);
        EpiResid E{H, H + (size_t)NPR * DM, H, XB, SSQ2, 1.0f, KB};
        pg8::gemm_phase<EpiResid, pg8::XcdOrder, true, true>(lds, g, S, E);
    }
    LSYNC();
    if (x_nx == 8) {
        for (int jr = x_r * NWAVES + wave; jr < 256; jr += x_nloc * NWAVES) {
            const int row = pg8::xcd_tile(x_xi, x_nx, x_T - 1) * 256 + jr;
            float* hr = H + (size_t)row * DM; f32x4 v[4]; float ss = 0.f;
#pragma unroll
            for (int j = 0; j < 4; ++j) { v[j] = *(const f32x4*)(hr + 4 * lane + 256 * j);
                f32x4 sm = {0.f, 0.f, 0.f, 0.f};
#pragma unroll
                for (int c = 0; c < 4; ++c) { const v2u pw = *(const v2u*)(KB + ((size_t)((row >> 8) - 64) * 8 + c) * 256 * DM + (size_t)(row & 255) * DM + 4 * lane + 256 * j);
                    sm.x += bflo(pw.x); sm.y += bfhi(pw.x); sm.z += bflo(pw.y); sm.w += bfhi(pw.y); }
                v[j] = v[j] + sm * 1.0f; *(f32x4*)(hr + 4 * lane + 256 * j) = v[j]; ss += (v[j].x * v[j].x + v[j].y * v[j].y) + (v[j].z * v[j].z + v[j].w * v[j].w); }
            ss = wave_sum(ss);
            if (lane < 16) SSQ2[(size_t)row * 16 + lane] = lane == 0 ? ss : 0.f;
            if (lane == 0) RSTD0[row] = 1.0f / sqrtf(ss * (1.0f / 1024.0f) + EPS);
#pragma unroll
            for (int j = 0; j < 4; ++j) { v2u w; w.x = pk2(v[j].x, v[j].y); w.y = pk2(v[j].z, v[j].w); *(v2u*)(XB + (size_t)row * DM + 4 * lane + 256 * j) = w; }
        }
        for (int jr = (x_r * NWAVES + wave) * 64 + lane; jr < (x_T - 1) * 256; jr += x_nloc * NWAVES * 64) {
            const int row = pg8::xcd_tile(x_xi, x_nx, jr >> 8) * 256 + (jr & 255);
            RSTD0[row] = row_rstd16(SSQ2, row);
        }
        LSYNC();
    }
    else { for (int jr = (x_r * NWAVES + wave) * 64 + lane; jr < x_T * 256; jr += x_nloc * NWAVES * 64) { const int row = pg8::xcd_tile(x_xi, x_nx, jr >> 8) * 256 + (jr & 255); RSTD0[row] = row_rstd16(SSQ2, row); }
        LSYNC(); }
    if (PHMASK & (1 << 7)) {
        pg8::Gemm g{XB, W2T, XB, W2T, NTOK, 2 * DFF, 1024}; pg8::XcdOrder S; S.init(NTOK, 2 * DFF, 1024, x_xi, x_nx, x_nloc, x_r, 0, 0);
        EpiSwiglu E{ACT, RSTD0, nullptr};
        pg8::gemm_phase<EpiSwiglu, pg8::XcdOrder, true, true>(lds, g, S, E);
    }
    LSYNC();
    if (PHMASK & (1 << 8)) {
        pg8::Gemm g{ACT, W2OT, ACT, W2OT, NTOK, 1024, DFF}; pg8::XcdOrder S; S.init(NTOK, 1024, DFF, x_xi, x_nx, x_nloc, x_r, 0, 1);
        EpiResidNorm E{H, SSQ3, KB, args.in[22], CTL + 7168, (x_nx == 8 && x_nloc == 32) ? 1 : 0};
        pg8::gemm_phase<EpiResidNorm, pg8::XcdOrder, true, true>(lds, g, S, E);
    }
    LSYNC();
#ifdef TSEL
    float tsD = 0.f;
    { volatile LAS unsigned long long* TS = (volatile LAS unsigned long long*)(lds + 131072 + 1024);
      if (bx == 0 && tid == 0) {
#ifdef P4PROBE
#if defined(P4PROBE2) || defined(P4PROBE3)
        const float us = (float)TS[42] * 0.01f, us2 = (float)TS[43] * 1.0f;
#else
        const float us = (float)TS[40] * 0.01f, us2 = (float)TS[41] * 0.01f;
#endif
#else
        const float us = (float)(TS[TSEL + 1] - TS[TSEL]) * 0.01f, us2 = (float)(TS[TSEL2 + 1] - TS[TSEL2]) * 0.01f;
#endif

        __hip_atomic_store((float*)(CTL + 8000), 8.0f + us * 0.01f, __ATOMIC_RELAXED, __HIP_MEMORY_SCOPE_AGENT); __hip_atomic_store((float*)(CTL + 8001), us2 * 0.02f, __ATOMIC_RELAXED, __HIP_MEMORY_SCOPE_AGENT); } }
    GSYNC();
    tsD = __hip_atomic_load((float*)(CTL + 8000), __ATOMIC_RELAXED, __HIP_MEMORY_SCOPE_AGENT); const float tsD2 = __hip_atomic_load((float*)(CTL + 8001), __ATOMIC_RELAXED, __HIP_MEMORY_SCOPE_AGENT);
#endif
    const int p9_lo = (x_nx == 8 && x_nloc == 32) ? (x_T - 1) * 256 : 0;
    if (PHMASK & (1 << 9)) for (int jr = p9_lo + x_r * NWAVES + wave; jr < x_T * 256; jr += x_nloc * NWAVES) {
        const int row = pg8::xcd_tile(x_xi, x_nx, jr >> 8) * 256 + (jr & 255);
        float* hr = H + (size_t)row * DM; f32x4 hv[4]; float ss9 = 0.f;
#pragma unroll
        for (int j = 0; j < 4; ++j) { hv[j] = *(const f32x4*)(hr + 4 * lane + 256 * j);
            if (x_nx == 8 && row >= NPR) { f32x4 sm = {0.f, 0.f, 0.f, 0.f};
#pragma unroll
                for (int c = 0; c < 8; ++c) { const v2u pw = *(const v2u*)(KB + ((size_t)((row >> 8) - 64) * 8 + c) * 256 * DM + (size_t)(row & 255) * DM + 4 * lane + 256 * j);
                    sm.x += bflo(pw.x); sm.y += bfhi(pw.x); sm.z += bflo(pw.y); sm.w += bfhi(pw.y); }
                hv[j] = hv[j] + sm * 0.5f; }
            ss9 += (hv[j].x * hv[j].x + hv[j].y * hv[j].y) + (hv[j].z * hv[j].z + hv[j].w * hv[j].w); }
        const float rs = 1.0f / sqrtf(wave_sum(ss9) * (1.0f / 1024.0f) + EPS);
#pragma unroll
        for (int j = 0; j < 4; ++j) { f32x4 v = hv[j]; const f32x4 g = *(const f32x4*)(args.in[22] + 4 * lane + 256 * j);
            v = v * rs * g;
#ifdef TSEL
            if (row == 0 && lane == 0 && j == 0) { v.x += tsD; v.y += tsD2; }
#endif
            *(f32x4*)(hr + 4 * lane + 256 * j) = v; }
    }
}

#undef ws
#undef out
#undef H
extern "C" void kernel_launch(void* const* d_in, const int* in_sizes, int n_in, void* d_out, int out_size, void* d_ws, size_t ws_size, hipStream_t stream) {
    static int grid = 0;
    if (grid == 0) {
        if (n_in != 23 || (size_t)out_size != O_END || ws_size < WS_END) { fprintf(stderr, "kernel_launch: unexpected shapes n_in %d out %d ws %zu\n", n_in, out_size, ws_size); grid = -1; return; }
        int dev = 0, cus = 0, per_cu = 0;
        hipGetDevice(&dev); hipDeviceGetAttribute(&cus, hipDeviceAttributeMultiprocessorCount, dev);
        if (hipFuncSetAttribute((const void*)mega_fwd, hipFuncAttributeMaxDynamicSharedMemorySize, LDS_BYTES) != hipSuccess) { fprintf(stderr, "kernel_launch: hipFuncSetAttribute failed\n"); grid = -1; return; }
        hipOccupancyMaxActiveBlocksPerMultiprocessor(&per_cu, (const void*)mega_fwd, 512, LDS_BYTES);
        (void)hipGetLastError();
        if (per_cu < 1) per_cu = 1;
        grid = cus;
        if (grid <= 0) grid = 256;
    }
    if (grid < 0) return;
    hipMemsetAsync((char*)d_ws + WS_CTL, 0, 64 * 1024, stream);
    Args a{};
    for (int i = 0; i < 23; ++i) a.in[i] = (const float*)d_in[i];
    a.out = (float*)d_out; a.ws = (unsigned char*)d_ws;
    for (int i = 0; i < 32; ++i) a.invf[i] = std::pow(10000.0, -(double)i / 32.0);
    void* kargs[] = {&a};
    hipError_t e = hipLaunchCooperativeKernel((const void*)mega_fwd, dim3(grid), dim3(512), kargs, LDS_BYTES, stream);
    if (e != hipSuccess) fprintf(stderr, "cooperative launch failed: %s (grid %d)\n", hipGetErrorString(e), grid);
}
```

```cpp
#include <hip/hip_runtime.h>
#include <hip/hip_cooperative_groups.h>
#include <cstdio>
#include <cstdint>
#include <cmath>
namespace cg = cooperative_groups;
namespace pg8 {
#define PG8_LAS __attribute__((address_space(3)))
typedef unsigned short bf16_t;
typedef short bf16x8 __attribute__((ext_vector_type(8)));
typedef float f32x4 __attribute__((ext_vector_type(4)));
typedef unsigned u32x4 __attribute__((ext_vector_type(4)));
constexpr int BM = 256, BK = 64, HALF = 128, HTB = HALF * BK * 2  , STAGE_BYTES = 8 * HTB, NXCD = 8, WGM = 8;

__host__ __device__ __forceinline__ int lds_byte(int r, int c) { const int st = (r >> 4) * 2 + (c >> 5), rr = r & 15, cc = c & 31, ob = rr * 64 + cc * 2; return st * 1024 + (ob ^ (((ob >> 9) & 1) << 5)); }
__host__ __device__ __forceinline__ void stage_rc(int b, int& R, int& C) { const int st = b / 1024, sb = b % 1024, swz = sb ^ (((sb >> 9) & 1) << 5); R = (st >> 1) * 16 + swz / 64; C = (st & 1) * 32 + (swz % 64) / 2; }
__host__ __device__ __forceinline__ int perm32(int rho) { const int n = rho >> 4, i = rho & 15; return 8 * (i >> 2) + 4 * n + (i & 3); }


struct Unit { int pm, pn, z, k0, nt, part; };
struct Gemm { const bf16_t* A; const bf16_t* Bt; const bf16_t* A2; const bf16_t* Bt2; int M, N, K; };

struct StaticOrder {
    int nM, nN, nwg, G, c, dbl;
    __host__ __device__ void init(int M, int N, int G_, int c_, int dbl_) { nM = M / BM; nN = N / BM; nwg = nM * nN; G = G_; c = c_; dbl = dbl_; }
    __host__ __device__ bool next(int i, Unit& u) const {
        const int ii = dbl ? (i >> 1) : i;
        const long L = (long)ii * G + c; if (L >= nwg) return false;
        int wgid = (int)L; { const int q = nwg / NXCD, r = nwg % NXCD, xcd = wgid % NXCD, off = wgid / NXCD; wgid = (xcd < r ? xcd * (q + 1) : r * (q + 1) + (xcd - r) * q) + off; }
        const int nig = WGM * nN, gid = wgid / nig, fm = gid * WGM, gsz = (nM - fm) < WGM ? (nM - fm) : WGM;
        u.pm = fm + ((wgid % nig) % gsz); u.pn = (wgid % nig) / gsz; u.z = dbl ? (i & 1) : 0; u.k0 = 0; u.nt = 0; u.part = 0; return true;
    }
    __device__ __forceinline__ void a_ready(const Unit&) const {}
    __device__ __forceinline__ void done(const Unit&) const {}
};

__device__ __forceinline__ int xcd_tile(int xi, int nx, int t) {
    if (nx != 8) return xi + nx * t;
    if (t >= 8) return 64 + xi;
    const int sg = t & 3; return (t >> 2) * 32 + sg * 8 + ((sg & 1) ? 7 - xi : xi);
}
struct XcdOrder {
    int nN, T, xi, nx, nloc, r, dbl, ntd, split;
    __device__ __forceinline__ void init(int M, int N, int K, int xi_, int nx_, int nloc_, int r_, int dbl_, int split_) { const int nM = M / BM; nN = N / BM; xi = xi_; nx = nx_; nloc = nloc_; r = r_; dbl = dbl_; ntd = K / BK;
        T = nx == 8 ? 9 : (nM - xi + nx - 1) / nx; split = (split_ && nx == 8 && nN == 4 && (ntd == 44 || ntd == 16)) ? 1 : 0; }
    __device__ __forceinline__ bool next(int i, Unit& u) const {
        const int ii = dbl ? (i >> 1) : i;
        const int j = ii * nloc + r; u.z = dbl ? (i & 1) : 0; u.k0 = 0; u.nt = ntd; u.part = 0;
        if (!split) { if (j >= T * nN) return false; u.pn = j / T; u.pm = xcd_tile(xi, nx, j - u.pn * T); return true; }
        const int nfull = (T - 1) * nN;
        if (j < nfull) { u.pn = j / (T - 1); u.pm = xcd_tile(xi, nx, j - u.pn * (T - 1)); return true; }
        const int jj = j - nfull, nch = ntd == 44 ? 8 : 4;
        if (jj >= nN * nch) return false;
        u.pn = jj / nch; const int c = jj - u.pn * nch; u.pm = xcd_tile(xi, nx, T - 1); u.part = 1 + c;
        if (ntd == 44) { u.k0 = c < 6 ? 6 * c : 36 + 4 * (c - 6); u.nt = c < 6 ? 6 : 4; } else { u.k0 = 4 * c; u.nt = 4; }
        return true;
    }
    __device__ __forceinline__ void a_ready(const Unit&) const {}
    __device__ __forceinline__ void done(const Unit&) const {}
};
typedef float f32x2_t_ __attribute__((ext_vector_type(2)));
typedef __bf16 bf16x2_t_ __attribute__((ext_vector_type(2)));
__device__ __forceinline__ unsigned cvt_pk_bf16(float lo, float hi) { const f32x2_t_ v = {lo, hi}; const bf16x2_t_ b = __builtin_convertvector(v, bf16x2_t_); return __builtin_bit_cast(unsigned, b); }

template <class Epi, class Sched, bool ALIGN_EPI = false, bool SP2 = false>
__device__ __forceinline__ void gemm_phase(PG8_LAS unsigned char* lds, const Gemm g, const Sched& S, const Epi& E) {
    int tid_ = threadIdx.x; asm volatile("" : "+v"(tid_));
    const int tid = tid_, wid = __builtin_amdgcn_readfirstlane(tid >> 6), lane = tid & 63, wr = wid >> 2, wc = wid & 3, fr = lane & 15, fq = lane >> 4;
    const int K = g.K, nt = K / BK;
    unsigned voffA[2], voffB[2];
#pragma unroll
    for (int i = 0; i < 2; ++i) { int R, C; stage_rc(tid * 16 + i * 8192, R, C); const int Rb = Epi::PERM ? ((R & ~31) + perm32(R & 31)) : R;
        voffA[i] = (unsigned)(R * K + C) * 2u; voffB[i] = (unsigned)(Rb * K + C) * 2u; }
    const size_t kstep = (size_t)(BK * 2);
    const size_t hstep = (size_t)HALF * K * 2;
    const size_t tstep = 2 * hstep;
    const unsigned ldsw = (unsigned)wid * 1024u;
    const int aoff = lds_byte(wr * 64 + fr, fq * 8), boff = lds_byte(wc * 32 + fr, fq * 8);
#define PG8_SA(b, h) (((b) * 2 + (h)) * HTB)
#define PG8_SB(b, h) ((4 + (b) * 2 + (h)) * HTB)
#define PG8_STAGE(bufoff, gbase, voff) do { _Pragma("unroll") for (int _i = 0; _i < 2; ++_i) \
        __builtin_amdgcn_global_load_lds((const unsigned*)((const char*)(gbase) + (voff)[_i]), (PG8_LAS unsigned*)(lds + (bufoff) + ldsw + _i * 8192), 16, 0, 0); } while (0)
#define PG8_LDA(dst, b, h) do { _Pragma("unroll") for (int m = 0; m < 4; ++m) _Pragma("unroll") for (int k = 0; k < 2; ++k) dst[m][k] = *(const PG8_LAS bf16x8*)(lds + PG8_SA(b, h) + aoff + m * 2048 + k * 1024); } while (0)
#define PG8_LDB(dst, b, h) do { _Pragma("unroll") for (int n = 0; n < 2; ++n) _Pragma("unroll") for (int k = 0; k < 2; ++k) dst[n][k] = *(const PG8_LAS bf16x8*)(lds + PG8_SB(b, h) + boff + n * 2048 + k * 1024); } while (0)
#define PG8_MMA(ai, bj, At, Bt) do { __builtin_amdgcn_s_setprio(1); _Pragma("unroll") for (int m = 0; m < 4; ++m) _Pragma("unroll") for (int n = 0; n < 2; ++n) _Pragma("unroll") for (int k = 0; k < 2; ++k) \
        acc[ai][bj][m][n] = __builtin_amdgcn_mfma_f32_16x16x32_bf16(Bt[n][k], At[m][k], acc[ai][bj][m][n], 0, 0, 0); __builtin_amdgcn_s_setprio(0); } while (0)
#define PG8_WAIT_V(n) asm volatile("s_waitcnt vmcnt(" #n ")" ::: "memory")
#define PG8_WAIT_L(n) asm volatile("s_waitcnt lgkmcnt(" #n ")" ::: "memory")
#define PG8_BAR __builtin_amdgcn_s_barrier()
#define PG8_SCHED __builtin_amdgcn_sched_barrier(0)
    Unit cur, nxt; int ui = 0;
    if (!S.next(0, cur)) return;
    f32x4 acc[2][2][4][2];
#pragma unroll
    for (int a = 0; a < 2; ++a)
#pragma unroll
        for (int b = 0; b < 2; ++b)
#pragma unroll
            for (int m = 0; m < 4; ++m)
#pragma unroll
                for (int n = 0; n < 2; ++n) acc[a][b][m][n] = (f32x4){0.f, 0.f, 0.f, 0.f};
    bf16x8 At[4][2], B0[2][2], B1[2][2];
    const char* cA = (const char*)(cur.z ? g.A2 : g.A) + (size_t)cur.pm * tstep + (size_t)cur.k0 * kstep; const char* cB = (const char*)(cur.z ? g.Bt2 : g.Bt) + (size_t)cur.pn * tstep + (size_t)cur.k0 * kstep;
    S.a_ready(cur);
    if constexpr (SP2) {
        PG8_STAGE(PG8_SB(0, 0), cB, voffB); PG8_STAGE(PG8_SB(0, 1), cB + hstep, voffB); PG8_STAGE(PG8_SA(0, 0), cA, voffA); PG8_STAGE(PG8_SA(0, 1), cA + hstep, voffA);
        if (wr == 1) PG8_BAR;
        PG8_WAIT_V(2); PG8_BAR;
        PG8_STAGE(PG8_SB(1, 0), cB + kstep, voffB); PG8_STAGE(PG8_SA(1, 0), cA + kstep, voffA); PG8_STAGE(PG8_SB(1, 1), cB + hstep + kstep, voffB);
        PG8_WAIT_V(6); PG8_BAR;
    } else {
        PG8_STAGE(PG8_SB(0, 0), cB, voffB); PG8_STAGE(PG8_SA(0, 0), cA, voffA); PG8_STAGE(PG8_SB(0, 1), cB + hstep, voffB); PG8_STAGE(PG8_SA(0, 1), cA + hstep, voffA);
        if (wr == 1) PG8_BAR;
        PG8_WAIT_V(4); PG8_BAR;
        PG8_STAGE(PG8_SB(1, 0), cB + kstep, voffB); PG8_STAGE(PG8_SA(1, 0), cA + kstep, voffA); PG8_STAGE(PG8_SB(1, 1), cB + hstep + kstep, voffB);
        PG8_WAIT_V(6); PG8_BAR;
    }
    for (;;) {
        const bool has_next = S.next(ui + 1, nxt);
        const char* nA = has_next ? (const char*)(nxt.z ? g.A2 : g.A) + (size_t)nxt.pm * tstep + (size_t)nxt.k0 * kstep : cA; const char* nB = has_next ? (const char*)(nxt.z ? g.Bt2 : g.Bt) + (size_t)nxt.pn * tstep + (size_t)nxt.k0 * kstep : cB;
        const int unt = cur.nt;
        for (int t = 0; t < unt; t += 2) {
            const bool last = (t == unt - 2);
            const char* a1 = cA + (size_t)(t + 1) * kstep;
            const char* a2 = last ? nA : cA + (size_t)(t + 2) * kstep; const char* b2 = last ? nB : cB + (size_t)(t + 2) * kstep;
            const char* a3 = a2 + kstep; const char* b3 = b2 + kstep;
            if (last && has_next) S.a_ready(nxt);
            if constexpr (SP2) {
            PG8_LDB(B0, 0, 0); PG8_LDB(B1, 0, 1); PG8_SCHED; PG8_LDA(At, 0, 0); PG8_STAGE(PG8_SA(1, 1), a1 + hstep, voffA);
            PG8_WAIT_V(8); PG8_WAIT_L(0); PG8_BAR; PG8_MMA(0, 0, At, B0); PG8_MMA(0, 1, At, B1); PG8_BAR; PG8_SCHED;
            PG8_LDA(At, 0, 1); PG8_STAGE(PG8_SB(0, 0), b2, voffB); PG8_STAGE(PG8_SB(0, 1), b2 + hstep, voffB); PG8_STAGE(PG8_SA(0, 0), a2, voffA);
            PG8_WAIT_V(8); PG8_WAIT_L(0); PG8_BAR; PG8_MMA(1, 0, At, B0); PG8_MMA(1, 1, At, B1); PG8_BAR; PG8_SCHED;
            PG8_LDB(B0, 1, 0); PG8_LDB(B1, 1, 1); PG8_SCHED; PG8_LDA(At, 1, 0); PG8_STAGE(PG8_SA(0, 1), a2 + hstep, voffA);
            PG8_WAIT_V(8); PG8_WAIT_L(0); PG8_BAR; PG8_MMA(0, 0, At, B0); PG8_MMA(0, 1, At, B1); PG8_BAR; PG8_SCHED;
            PG8_LDA(At, 1, 1); PG8_STAGE(PG8_SB(1, 0), b3, voffB); PG8_STAGE(PG8_SB(1, 1), b3 + hstep, voffB); PG8_STAGE(PG8_SA(1, 0), a3, voffA);
            PG8_WAIT_V(8); PG8_WAIT_L(0); PG8_BAR; PG8_MMA(1, 0, At, B0); PG8_MMA(1, 1, At, B1); PG8_BAR; PG8_SCHED;
            } else {
            PG8_LDB(B0, 0, 0); PG8_SCHED; PG8_LDA(At, 0, 0); PG8_STAGE(PG8_SA(1, 1), a1 + hstep, voffA);
            PG8_WAIT_L(8); PG8_BAR; PG8_WAIT_L(0); PG8_MMA(0, 0, At, B0); PG8_BAR; PG8_SCHED;
            PG8_LDB(B1, 0, 1); PG8_STAGE(PG8_SB(0, 0), b2, voffB);
            PG8_BAR; PG8_WAIT_L(0); PG8_MMA(0, 1, At, B1); PG8_BAR;
            PG8_LDA(At, 0, 1); PG8_STAGE(PG8_SA(0, 0), a2, voffA);
            PG8_BAR; PG8_WAIT_L(0); PG8_MMA(1, 0, At, B0); PG8_BAR; PG8_SCHED;
            PG8_STAGE(PG8_SB(0, 1), b2 + hstep, voffB);
            PG8_WAIT_V(6); PG8_BAR; PG8_MMA(1, 1, At, B1); PG8_BAR;
            PG8_LDB(B0, 1, 0); PG8_SCHED; PG8_LDA(At, 1, 0); PG8_STAGE(PG8_SA(0, 1), a2 + hstep, voffA);
            PG8_WAIT_L(8); PG8_BAR; PG8_WAIT_L(0); PG8_MMA(0, 0, At, B0); PG8_BAR; PG8_SCHED;
            PG8_LDB(B1, 1, 1); PG8_STAGE(PG8_SB(1, 0), b3, voffB);
            PG8_BAR; PG8_WAIT_L(0); PG8_MMA(0, 1, At, B1); PG8_BAR;
            PG8_LDA(At, 1, 1); PG8_STAGE(PG8_SA(1, 0), a3, voffA);
            PG8_BAR; PG8_WAIT_L(0); PG8_MMA(1, 0, At, B0); PG8_BAR; PG8_SCHED;
            PG8_STAGE(PG8_SB(1, 1), b3 + hstep, voffB);
            PG8_WAIT_V(6); PG8_BAR; PG8_MMA(1, 1, At, B1); PG8_BAR;
            }
        }
        if constexpr (ALIGN_EPI) { if (wr == 0) PG8_BAR; }
        if constexpr (!Epi::AFTER_DRAIN) { E(acc, cur, wr, wc, fr, fq); S.done(cur); }
        if (!has_next) break;
#pragma unroll
        for (int a = 0; a < 2; ++a)
#pragma unroll
            for (int b = 0; b < 2; ++b)
#pragma unroll
                for (int m = 0; m < 4; ++m)
#pragma unroll
                    for (int n = 0; n < 2; ++n) acc[a][b][m][n] = (f32x4){0.f, 0.f, 0.f, 0.f};
        cur = nxt; cA = nA; cB = nB; ++ui;
        if constexpr (ALIGN_EPI) { if (wr == 1) PG8_BAR; }
    }
    PG8_WAIT_V(0);
    if constexpr (!ALIGN_EPI) { if (wr == 0) PG8_BAR; }
    PG8_BAR;
    if constexpr (Epi::AFTER_DRAIN) { E.fused(acc, cur, wr, wc, fr, fq, lds, wid, lane); S.done(cur); }
#undef PG8_SA
#undef PG8_SB
#undef PG8_STAGE
#undef PG8_LDA
#undef PG8_LDB
#undef PG8_MMA
#undef PG8_WAIT_V
#undef PG8_WAIT_L
#undef PG8_BAR
#undef PG8_SCHED
}
}

#define GAS __attribute__((address_space(1)))
#define LAS __attribute__((address_space(3)))
typedef unsigned short bf16;
typedef unsigned v4u __attribute__((ext_vector_type(4)));
typedef unsigned v2u __attribute__((ext_vector_type(2)));
typedef float f32x4 __attribute__((ext_vector_type(4)));
typedef short bf16x8 __attribute__((ext_vector_type(8)));
typedef _Float16 h16x8 __attribute__((ext_vector_type(8)));
using pg8::cvt_pk_bf16;

constexpr int DM = 1024, NTOK = 18432, NPR = 16384, TPR = 8192, TSM = 64, PAST = 1024, LSM = 1088;
constexpr int DFF = 2816, NIN = 4608, NWAVES = 8;
constexpr float EPS = 1e-6f;
constexpr size_t KiB = 1024, MiB = 1u << 20;
constexpr size_t WS_CTL = 0;
constexpr size_t WS_RSTD0 = 64 * KiB;
constexpr size_t WS_WI = 192 * KiB;
constexpr size_t WS_SSQ1 = 768 * KiB;
constexpr size_t WS_SSQ2 = 1920 * KiB;
constexpr size_t WS_SSQ3 = WS_SSQ1;
constexpr size_t WS_HALO_A = 3 * MiB;
constexpr size_t WS_COS = 4 * MiB + 256 * KiB;
constexpr size_t WS_SIN = 5 * MiB + 256 * KiB;
constexpr size_t WS_W1T = 6 * MiB + 256 * KiB;
constexpr size_t WS_W1OT = WS_W1T + 11 * MiB;
constexpr size_t WS_WINT = WS_W1OT + 5 * MiB + 512 * KiB;
constexpr size_t WS_WCOT = WS_WINT + 9 * MiB;
constexpr size_t WS_WAOT = WS_WCOT + 1 * MiB;
constexpr size_t WS_WOT = WS_WAOT + 1 * MiB;
constexpr size_t WS_W2T = WS_WOT + 2 * MiB;
constexpr size_t WS_W2OT = WS_W2T + 11 * MiB;
constexpr size_t WS_XB = WS_W2OT + 5 * MiB + 512 * KiB;
constexpr size_t WS_AO = WS_XB, WS_CA = WS_XB + 18 * MiB;
constexpr size_t WS_ACT = WS_XB + 36 * MiB;
constexpr size_t WS_GATE = WS_ACT, WS_C = WS_ACT + 72 * MiB;
constexpr size_t WS_Q = WS_ACT + 99 * MiB;
constexpr size_t WS_QI = WS_Q + 18 * MiB;
constexpr size_t WS_MERGED = WS_Q;
constexpr size_t WS_KB = WS_QI + 18 * MiB;
constexpr size_t WS_VB = WS_KB + 12 * MiB + 512 * KiB;
constexpr size_t WS_KIB = WS_VB + 12 * MiB + 512 * KiB;
constexpr size_t WS_HALO_B = WS_KIB + 6 * MiB + 256 * KiB;
constexpr size_t WS_END = WS_HALO_B + 1 * MiB;
static_assert(WS_END <= 256 * MiB, "workspace map");
constexpr size_t O_Y = 0, O_KP = 18874368, O_VP = O_KP + 2097152, O_IP = O_VP + 2097152, O_CP = O_IP + 1048576, O_KS = O_CP + 30720,
                 O_VS = O_KS + 262144, O_IS = O_VS + 262144, O_CS = O_IS + 131072, O_END = O_CS + 491520;
constexpr int LDS_BYTES = 147456;
constexpr int CAP = 1280;
constexpr int CAPS = CAP + 8;
constexpr int L_VAL = 0, L_IDX = 16 * CAPS * 4, L_HIST = L_IDX + 16 * CAPS * 2, L_CNT = L_HIST + 512, L_TAU = L_CNT + 64, L_ITEM = L_CNT + 128;
static_assert(L_ITEM + 64 <= 131072, "P4 LDS map");

#define LDS_WAIT() asm volatile("s_waitcnt lgkmcnt(0)" ::: "memory")
__device__ __forceinline__ unsigned f2bf(float f) { unsigned u = __builtin_bit_cast(unsigned, f); return (u + 0x7fffu + ((u >> 16) & 1u)) >> 16; }
__device__ __forceinline__ unsigned pk2(float lo, float hi) { return f2bf(lo) | (f2bf(hi) << 16); }
__device__ __forceinline__ unsigned pkh(float lo, float hi) { _Float16 a = (_Float16)lo, b = (_Float16)hi; return (unsigned)__builtin_bit_cast(unsigned short, a) | ((unsigned)__builtin_bit_cast(unsigned short, b) << 16); }
__device__ __forceinline__ float bflo(unsigned v) { return __uint_as_float(v << 16); }
__device__ __forceinline__ float bfhi(unsigned v) { return __uint_as_float(v & 0xffff0000u); }
__device__ __forceinline__ float wave_sum(float v) {
#pragma unroll
    for (int o = 1; o < 64; o <<= 1) v += __shfl_xor(v, o);
    return v;
}
__device__ __forceinline__ float sigmoidf_(float x) { return __builtin_amdgcn_rcpf(1.0f + __expf(-x)); }
__device__ __forceinline__ float siluf_(float x) { return x * sigmoidf_(x); }

struct Args { const float* in[23]; float* out; unsigned char* ws; double invf[32]; };

__device__ __forceinline__ float row_rstd16(const float* ssq, int row) {
    const f32x4* p = (const f32x4*)(ssq + (size_t)row * 16);
    f32x4 a = p[0], b = p[1], c = p[2], d = p[3];
    float s = ((a.x + a.y) + (a.z + a.w)) + ((b.x + b.y) + (b.z + b.w)) + ((c.x + c.y) + (c.z + c.w)) + ((d.x + d.y) + (d.z + d.w));
    return 1.0f / sqrtf(s * (1.0f / 1024.0f) + EPS);
}

struct EpiSwiglu {
    static constexpr bool PERM = true, AFTER_DRAIN = false;
    bf16* act; const float* rstd; const float* ssq;
    __device__ __forceinline__ void operator()(const f32x4 (&acc)[2][2][4][2], const pg8::Unit& u, int wr, int wc, int fr, int fq) const {
        asm volatile("" : "+v"(fr), "+v"(fq));
#pragma unroll
        for (int ai = 0; ai < 2; ++ai)
#pragma unroll
            for (int m = 0; m < 4; ++m) {
                const int row = u.pm * 256 + ai * 128 + wr * 64 + m * 16 + fr;
                const float rs = rstd ? rstd[row] : row_rstd16(ssq, row);
                float o[8];
#pragma unroll
                for (int n = 0; n < 2; ++n)
#pragma unroll
                    for (int j = 0; j < 4; ++j) { const float a = acc[ai][0][m][n][j] * rs, b = acc[ai][1][m][n][j] * rs; o[n * 4 + j] = siluf_(a) * b; }
                v4u w; w.x = cvt_pk_bf16(o[0], o[1]); w.y = cvt_pk_bf16(o[2], o[3]); w.z = cvt_pk_bf16(o[4], o[5]); w.w = cvt_pk_bf16(o[6], o[7]);
                *(v4u*)(act + (size_t)row * DFF + u.pn * 128 + wc * 32 + fq * 8) = w;
            }
    }
};

struct EpiResid {
    static constexpr bool PERM = true, AFTER_DRAIN = false;
    const float* baseP; const float* baseS;
    float* h; bf16* hb; float* ssq; float scale; bf16* part;
    __device__ __forceinline__ void operator()(const f32x4 (&acc)[2][2][4][2], const pg8::Unit& u, int wr, int wc, int fr, int fq) const {
        asm volatile("" : "+v"(fr), "+v"(fq));
#pragma unroll
        for (int ai = 0; ai < 2; ++ai)
#pragma unroll
            for (int m = 0; m < 4; ++m) {
                const int row = u.pm * 256 + ai * 128 + wr * 64 + m * 16 + fr;
                if (u.part) {
                    bf16* pp = part + ((size_t)((u.pm - 64) * 8 + (u.part - 1)) * 256 + (row & 255)) * DM + u.pn * 256 + wc * 32 + fq * 8;
#pragma unroll
                    for (int bj = 0; bj < 2; ++bj) { v4u w; w.x = cvt_pk_bf16(acc[ai][bj][m][0].x, acc[ai][bj][m][0].y); w.y = cvt_pk_bf16(acc[ai][bj][m][0].z, acc[ai][bj][m][0].w);
                        w.z = cvt_pk_bf16(acc[ai][bj][m][1].x, acc[ai][bj][m][1].y); w.w = cvt_pk_bf16(acc[ai][bj][m][1].z, acc[ai][bj][m][1].w); *(v4u*)(pp + bj * 128) = w; }
                    continue;
                }
                const float* bp = row < NPR ? baseP + (size_t)row * DM : baseS + (size_t)(row - NPR) * DM;
                float ss = 0.f;
#pragma unroll
                for (int bj = 0; bj < 2; ++bj) {
                    const int col = u.pn * 256 + bj * 128 + wc * 32 + fq * 8;
                    f32x4 v0 = *(const f32x4*)(bp + col), v1 = *(const f32x4*)(bp + col + 4);
                    v0 = v0 + acc[ai][bj][m][0] * scale; v1 = v1 + acc[ai][bj][m][1] * scale;
                    *(f32x4*)(h + (size_t)row * DM + col) = v0; *(f32x4*)(h + (size_t)row * DM + col + 4) = v1;
                    ss += (v0.x * v0.x + v0.y * v0.y) + (v0.z * v0.z + v0.w * v0.w) + (v1.x * v1.x + v1.y * v1.y) + (v1.z * v1.z + v1.w * v1.w);
                    if (hb) { v4u w; w.x = cvt_pk_bf16(v0.x, v0.y); w.y = cvt_pk_bf16(v0.z, v0.w); w.z = cvt_pk_bf16(v1.x, v1.y); w.w = cvt_pk_bf16(v1.z, v1.w);
                              *(v4u*)(hb + (size_t)row * DM + col) = w; }
                }
                ss += __shfl_xor(ss, 16); ss += __shfl_xor(ss, 32);
                if (fq == 0) ssq[(size_t)row * 16 + u.pn * 4 + wc] = ss;
            }
    }
};

struct EpiResidNorm {
    static constexpr bool PERM = true, AFTER_DRAIN = false;
    float* h; float* ssq; bf16* part; const float* gfn; unsigned* ctr; int fuse;
    __device__ __forceinline__ void operator()(f32x4 (&acc)[2][2][4][2], const pg8::Unit& u, int wr, int wc, int fr, int fq) const {
        asm volatile("" : "+v"(fr), "+v"(fq));
        if (u.part) {
#pragma unroll
            for (int ai = 0; ai < 2; ++ai)
#pragma unroll
                for (int m = 0; m < 4; ++m) { const int row = u.pm * 256 + ai * 128 + wr * 64 + m * 16 + fr;
                    bf16* pp = part + ((size_t)((u.pm - 64) * 8 + (u.part - 1)) * 256 + (row & 255)) * DM + u.pn * 256 + wc * 32 + fq * 8;
#pragma unroll
                    for (int bj = 0; bj < 2; ++bj) { v4u w; w.x = cvt_pk_bf16(acc[ai][bj][m][0].x, acc[ai][bj][m][0].y); w.y = cvt_pk_bf16(acc[ai][bj][m][0].z, acc[ai][bj][m][0].w);
                        w.z = cvt_pk_bf16(acc[ai][bj][m][1].x, acc[ai][bj][m][1].y); w.w = cvt_pk_bf16(acc[ai][bj][m][1].z, acc[ai][bj][m][1].w); *(v4u*)(pp + bj * 128) = w; } }
            return;
        }
#pragma unroll
        for (int ai = 0; ai < 2; ++ai)
#pragma unroll
            for (int m = 0; m < 4; ++m) {
                const int row = u.pm * 256 + ai * 128 + wr * 64 + m * 16 + fr;
                float ss = 0.f;
#pragma unroll
                for (int bj = 0; bj < 2; ++bj) {
                    float* hp = h + (size_t)row * DM + u.pn * 256 + bj * 128 + wc * 32 + fq * 8;
                    f32x4 v0 = *(const f32x4*)hp, v1 = *(const f32x4*)(hp + 4);
                    v0 = v0 + acc[ai][bj][m][0] * 0.5f; v1 = v1 + acc[ai][bj][m][1] * 0.5f;
                    acc[ai][bj][m][0] = v0; acc[ai][bj][m][1] = v1;
                    if (!fuse) { *(f32x4*)hp = v0; *(f32x4*)(hp + 4) = v1; }
                    ss += (v0.x * v0.x + v0.y * v0.y) + (v0.z * v0.z + v0.w * v0.w) + (v1.x * v1.x + v1.y * v1.y) + (v1.z * v1.z + v1.w * v1.w);
                }
                ss += __shfl_xor(ss, 16); ss += __shfl_xor(ss, 32);
                if (fq == 0) ssq[(size_t)row * 16 + u.pn * 4 + wc] = ss;
            }
        if (!fuse) return;
        asm volatile("s_waitcnt vmcnt(0)" ::: "memory"); __syncthreads();
        if (threadIdx.x == 0) { unsigned* cp = ctr + 64 * u.pm; __hip_atomic_fetch_add(cp, 1u, __ATOMIC_RELAXED, __HIP_MEMORY_SCOPE_AGENT); unsigned sp = 0u;
            while (__hip_atomic_load(cp, __ATOMIC_RELAXED, __HIP_MEMORY_SCOPE_AGENT) < 4u) { __builtin_amdgcn_s_sleep(2); if (++sp > (1u << 22)) break; }
            __builtin_amdgcn_fence(__ATOMIC_ACQUIRE, "agent"); asm volatile("s_waitcnt vmcnt(0)" ::: "memory"); }
        __syncthreads();
        const int colg = u.pn * 256 + wc * 32 + fq * 8;
        const f32x4 g00 = *(const f32x4*)(gfn + colg), g01 = *(const f32x4*)(gfn + colg + 4), g10 = *(const f32x4*)(gfn + colg + 128), g11 = *(const f32x4*)(gfn + colg + 132);
#pragma unroll
        for (int ai = 0; ai < 2; ++ai)
#pragma unroll
            for (int m = 0; m < 4; ++m) {
                const int row = u.pm * 256 + ai * 128 + wr * 64 + m * 16 + fr;
                const float rs = row_rstd16(ssq, row);
                float* hp = h + (size_t)row * DM + colg;
                *(f32x4*)hp = acc[ai][0][m][0] * rs * g00; *(f32x4*)(hp + 4) = acc[ai][0][m][1] * rs * g01;
                *(f32x4*)(hp + 128) = acc[ai][1][m][0] * rs * g10; *(f32x4*)(hp + 132) = acc[ai][1][m][1] * rs * g11;
            }
    }
};

struct EpiMix {
    static constexpr bool PERM = true, AFTER_DRAIN = false;
    const float* ssq; const float* cosT; const float* sinT; const float* bgate;
    bf16* Q; unsigned short* QI; bf16* KB; bf16* VB; unsigned short* KIB; float* WI; bf16* C; bf16* G; float* out; unsigned char* wsb;
    __device__ __forceinline__ void operator()(const f32x4 (&acc)[2][2][4][2], const pg8::Unit& u, int wr, int wc, int fr, int fq) const {
        asm volatile("" : "+v"(fr), "+v"(fq));
        const int pn = u.pn;
        float rsv[8];
#pragma unroll
        for (int i8 = 0; i8 < 8; ++i8) rsv[i8] = ssq[u.pm * 256 + (i8 >> 2) * 128 + wr * 64 + (i8 & 3) * 16 + fr];
        f32x4 gb0 = {0.f, 0.f, 0.f, 0.f}, gb1 = gb0, gb2 = gb0, gb3 = gb0;
        if (pn >= 10) { const int colb = (pn - 10) * 256 + wc * 32 + fq * 8; gb0 = *(const f32x4*)(bgate + colb); gb1 = *(const f32x4*)(bgate + colb + 4); gb2 = *(const f32x4*)(bgate + colb + 128); gb3 = *(const f32x4*)(bgate + colb + 132); }
#pragma unroll
        for (int ai = 0; ai < 2; ++ai)
#pragma unroll
            for (int m = 0; m < 4; ++m) {
                const int row = u.pm * 256 + ai * 128 + wr * 64 + m * 16 + fr;
                const float rs = rsv[ai * 4 + m];
                const bool smp = row >= NPR;
                const int sb = (row - NPR) >> 6, sj = (row - NPR) & 63;
                const int pos = smp ? PAST + sj : (row & (TPR - 1));
                const int krow = smp ? NPR + sb * LSM + PAST + sj : row;
                float lo[8], hi[8];
#pragma unroll
                for (int n = 0; n < 2; ++n)
#pragma unroll
                    for (int j = 0; j < 4; ++j) { lo[n * 4 + j] = acc[ai][0][m][n][j] * rs; hi[n * 4 + j] = acc[ai][1][m][n][j] * rs; }
                const bool is_rope = (pn < 4) || (pn == 4 && wc < 2) || (pn == 5 && wc == 0);
                if (is_rope) {
                    const f32x4 c0 = *(const f32x4*)(cosT + pos * 32 + fq * 8), c1 = *(const f32x4*)(cosT + pos * 32 + fq * 8 + 4);
                    const f32x4 s0 = *(const f32x4*)(sinT + pos * 32 + fq * 8), s1 = *(const f32x4*)(sinT + pos * 32 + fq * 8 + 4);
                    const float cs[8] = {c0.x, c0.y, c0.z, c0.w, c1.x, c1.y, c1.z, c1.w}, sn[8] = {s0.x, s0.y, s0.z, s0.w, s1.x, s1.y, s1.z, s1.w};
#pragma unroll
                    for (int i = 0; i < 8; ++i) { const float a = lo[i], b = hi[i]; lo[i] = a * cs[i] - b * sn[i]; hi[i] = b * cs[i] + a * sn[i]; }
                    if (pn < 2) {
                        bf16* p = Q + (size_t)row * 512 + (4 * pn + wc) * 64 + fq * 8;
                        v4u w; w.x = cvt_pk_bf16(lo[0], lo[1]); w.y = cvt_pk_bf16(lo[2], lo[3]); w.z = cvt_pk_bf16(lo[4], lo[5]); w.w = cvt_pk_bf16(lo[6], lo[7]); *(v4u*)p = w;
                        w.x = cvt_pk_bf16(hi[0], hi[1]); w.y = cvt_pk_bf16(hi[2], hi[3]); w.z = cvt_pk_bf16(hi[4], hi[5]); w.w = cvt_pk_bf16(hi[6], hi[7]); *(v4u*)(p + 32) = w;
                    } else if (pn < 4) {
                        unsigned short* p = QI + (size_t)row * 512 + (4 * (pn - 2) + wc) * 64 + fq * 8;
                        v4u w; w.x = pkh(lo[0], lo[1]); w.y = pkh(lo[2], lo[3]); w.z = pkh(lo[4], lo[5]); w.w = pkh(lo[6], lo[7]); *(v4u*)p = w;
                        w.x = pkh(hi[0], hi[1]); w.y = pkh(hi[2], hi[3]); w.z = pkh(hi[4], hi[5]); w.w = pkh(hi[6], hi[7]); *(v4u*)(p + 32) = w;
                    } else if (pn == 4) {
                        float* o = out + (smp ? O_KS + (size_t)(row - NPR) * 128 : O_KP + (size_t)row * 128) + wc * 64 + fq * 8;
                        *(f32x4*)o = (f32x4){lo[0], lo[1], lo[2], lo[3]}; *(f32x4*)(o + 4) = (f32x4){lo[4], lo[5], lo[6], lo[7]};
                        *(f32x4*)(o + 32) = (f32x4){hi[0], hi[1], hi[2], hi[3]}; *(f32x4*)(o + 36) = (f32x4){hi[4], hi[5], hi[6], hi[7]};
                        bf16* p = KB + (size_t)krow * 128 + wc * 64 + fq * 8;
                        v4u w; w.x = cvt_pk_bf16(lo[0], lo[1]); w.y = cvt_pk_bf16(lo[2], lo[3]); w.z = cvt_pk_bf16(lo[4], lo[5]); w.w = cvt_pk_bf16(lo[6], lo[7]); *(v4u*)p = w;
                        w.x = cvt_pk_bf16(hi[0], hi[1]); w.y = cvt_pk_bf16(hi[2], hi[3]); w.z = cvt_pk_bf16(hi[4], hi[5]); w.w = cvt_pk_bf16(hi[6], hi[7]); *(v4u*)(p + 32) = w;
                    } else {
                        float* o = out + (smp ? O_IS + (size_t)(row - NPR) * 64 : O_IP + (size_t)row * 64) + fq * 8;
                        *(f32x4*)o = (f32x4){lo[0], lo[1], lo[2], lo[3]}; *(f32x4*)(o + 4) = (f32x4){lo[4], lo[5], lo[6], lo[7]};
                        *(f32x4*)(o + 32) = (f32x4){hi[0], hi[1], hi[2], hi[3]}; *(f32x4*)(o + 36) = (f32x4){hi[4], hi[5], hi[6], hi[7]};
                        unsigned short* p = KIB + (size_t)krow * 64 + fq * 8;
                        v4u w; w.x = pkh(lo[0], lo[1]); w.y = pkh(lo[2], lo[3]); w.z = pkh(lo[4], lo[5]); w.w = pkh(lo[6], lo[7]); *(v4u*)p = w;
                        w.x = pkh(hi[0], hi[1]); w.y = pkh(hi[2], hi[3]); w.z = pkh(hi[4], hi[5]); w.w = pkh(hi[6], hi[7]); *(v4u*)(p + 32) = w;
                    }
                } else if (pn == 4) {
                    const int vc = (wc - 2) * 32 + fq * 8;
                    float* o = out + (smp ? O_VS + (size_t)(row - NPR) * 128 : O_VP + (size_t)row * 128) + vc;
                    *(f32x4*)o = (f32x4){lo[0], lo[1], lo[2], lo[3]}; *(f32x4*)(o + 4) = (f32x4){lo[4], lo[5], lo[6], lo[7]};
                    *(f32x4*)(o + 64) = (f32x4){hi[0], hi[1], hi[2], hi[3]}; *(f32x4*)(o + 68) = (f32x4){hi[4], hi[5], hi[6], hi[7]};
                    bf16* p = VB + (size_t)krow * 128 + vc;
                    v4u w; w.x = cvt_pk_bf16(lo[0], lo[1]); w.y = cvt_pk_bf16(lo[2], lo[3]); w.z = cvt_pk_bf16(lo[4], lo[5]); w.w = cvt_pk_bf16(lo[6], lo[7]); *(v4u*)p = w;
                    w.x = cvt_pk_bf16(hi[0], hi[1]); w.y = cvt_pk_bf16(hi[2], hi[3]); w.z = cvt_pk_bf16(hi[4], hi[5]); w.w = cvt_pk_bf16(hi[6], hi[7]); *(v4u*)(p + 64) = w;
                } else if (pn == 5) {
                    if (wc == 1 && fq == 0) {
                        const float sc = 0.35355339059327373f;
                        float* o = WI + (size_t)row * 8;
                        *(f32x4*)o = (f32x4){lo[0] * sc, lo[1] * sc, lo[2] * sc, lo[3] * sc}; *(f32x4*)(o + 4) = (f32x4){lo[4] * sc, lo[5] * sc, lo[6] * sc, lo[7] * sc};
                    }
                } else if (pn < 10) {
                    const int ch = (pn - 6) * 128 + wc * 32 + fq * 8;
                    float cv[8];
#pragma unroll
                    for (int i = 0; i < 8; ++i) cv[i] = lo[i] * sigmoidf_(hi[i]);
                    v4u w; w.x = cvt_pk_bf16(cv[0], cv[1]); w.y = cvt_pk_bf16(cv[2], cv[3]); w.z = cvt_pk_bf16(cv[4], cv[5]); w.w = cvt_pk_bf16(cv[6], cv[7]);
                    *(v4u*)(C + (size_t)row * DFF + ch) = w;
                    if (!smp && (row & 255) >= 226 && ((row >> 8) & 31) != 31) { const int p = row >> 8;
                        *(v4u*)((bf16*)(wsb + ((p >> 5) ? WS_HALO_B : WS_HALO_A)) + (size_t)((p & 31) * 30 + (row & 255) - 226) * 512 + ch) = w; }
                    int crow = -1; size_t cb = 0;
                    if (smp) { if (sj >= 34) { crow = sb * 30 + sj - 34; cb = O_CS; } }
                    else { const int b = row >> 13; if (pos >= TPR - 30) { crow = b * 30 + pos - (TPR - 30); cb = O_CP; } }
                    if (crow >= 0) { float* o = out + cb + (size_t)crow * 512 + ch;
                        *(f32x4*)o = (f32x4){cv[0], cv[1], cv[2], cv[3]}; *(f32x4*)(o + 4) = (f32x4){cv[4], cv[5], cv[6], cv[7]}; }
                } else {
                    const int col = (pn - 10) * 256 + wc * 32 + fq * 8;
                    const f32x4 b0 = gb0, b1 = gb1, b2 = gb2, b3 = gb3;
                    v4u w; w.x = cvt_pk_bf16(sigmoidf_(lo[0] + b0.x), sigmoidf_(lo[1] + b0.y)); w.y = cvt_pk_bf16(sigmoidf_(lo[2] + b0.z), sigmoidf_(lo[3] + b0.w));
                    w.z = cvt_pk_bf16(sigmoidf_(lo[4] + b1.x), sigmoidf_(lo[5] + b1.y)); w.w = cvt_pk_bf16(sigmoidf_(lo[6] + b1.z), sigmoidf_(lo[7] + b1.w));
                    *(v4u*)(G + (size_t)row * DFF + col) = w;
                    w.x = cvt_pk_bf16(sigmoidf_(hi[0] + b2.x), sigmoidf_(hi[1] + b2.y)); w.y = cvt_pk_bf16(sigmoidf_(hi[2] + b2.z), sigmoidf_(hi[3] + b2.w));
                    w.z = cvt_pk_bf16(sigmoidf_(hi[4] + b3.x), sigmoidf_(hi[5] + b3.y)); w.w = cvt_pk_bf16(sigmoidf_(hi[6] + b3.z), sigmoidf_(hi[7] + b3.w));
                    *(v4u*)(G + (size_t)row * DFF + col + 128) = w;
                }
                asm volatile("" ::: "memory");
            }
    }
};

struct EpiMerge {
    static constexpr bool PERM = true, AFTER_DRAIN = false;
    const bf16* G; bf16* MG;
    __device__ __forceinline__ void operator()(const f32x4 (&acc)[2][2][4][2], const pg8::Unit& u, int wr, int wc, int fr, int fq) const {
        asm volatile("" : "+v"(fr), "+v"(fq));
#pragma unroll
        for (int ai = 0; ai < 2; ++ai)
#pragma unroll
            for (int m = 0; m < 4; ++m) {
                const int row = u.pm * 256 + ai * 128 + wr * 64 + m * 16 + fr;
#pragma unroll
                for (int bj = 0; bj < 2; ++bj) {
                    const int col = u.pn * 256 + bj * 128 + wc * 32 + fq * 8;
                    const v4u g = *(const v4u*)(G + (size_t)row * DFF + (u.z ? 1024 : 0) + col);
                    float o[8];
                    o[0] = bflo(g.x) * acc[ai][bj][m][0].x; o[1] = bfhi(g.x) * acc[ai][bj][m][0].y; o[2] = bflo(g.y) * acc[ai][bj][m][0].z; o[3] = bfhi(g.y) * acc[ai][bj][m][0].w;
                    o[4] = bflo(g.z) * acc[ai][bj][m][1].x; o[5] = bfhi(g.z) * acc[ai][bj][m][1].y; o[6] = bflo(g.w) * acc[ai][bj][m][1].z; o[7] = bfhi(g.w) * acc[ai][bj][m][1].w;
                    bf16* p = MG + (size_t)row * DM + col;
                    if (u.z) { const v4u t = *(const v4u*)p;
                        o[0] += bflo(t.x); o[1] += bfhi(t.x); o[2] += bflo(t.y); o[3] += bfhi(t.y); o[4] += bflo(t.z); o[5] += bfhi(t.z); o[6] += bflo(t.w); o[7] += bfhi(t.w); }
                    v4u w; w.x = cvt_pk_bf16(o[0], o[1]); w.y = cvt_pk_bf16(o[2], o[3]); w.z = cvt_pk_bf16(o[4], o[5]); w.w = cvt_pk_bf16(o[6], o[7]);
                    *(v4u*)p = w;
                }
            }
    }
};

__device__ __forceinline__ void p0_transpose_item(const float* W, int K, int N, bf16* WT, int src0, int nvalid, int dst0, const float* gain, int kb, LAS float* scr, int lane) {
    const int k0 = 64 * kb;
#pragma unroll
    for (int i = 0; i < 8; ++i) { const int kk = 8 * i + (lane >> 3), n4 = (lane & 7) * 4;
        f32x4 v = (n4 < nvalid) ? *(const f32x4*)(W + (size_t)(k0 + kk) * N + src0 + n4) : (f32x4){0.f, 0.f, 0.f, 0.f};
        if (gain) v = v * gain[k0 + kk];
        LAS float* d = scr + kk * 33 + n4; d[0] = v.x; d[1] = v.y; d[2] = v.z; d[3] = v.w; }
    LDS_WAIT(); asm volatile("" ::: "memory");
    const int c = lane & 7;
#pragma unroll
    for (int j = 0; j < 4; ++j) { const int n = (lane >> 3) + 8 * j; const LAS float* s = scr + (8 * c) * 33 + n;
        v4u o; o.x = pk2(s[0 * 33], s[1 * 33]); o.y = pk2(s[2 * 33], s[3 * 33]); o.z = pk2(s[4 * 33], s[5 * 33]); o.w = pk2(s[6 * 33], s[7 * 33]);
        *(v4u*)(WT + (size_t)(dst0 + n) * K + k0 + 8 * c) = o; }
    LDS_WAIT(); asm volatile("" ::: "memory");
}
__device__ __forceinline__ int map_swiglu(int R) { const int pn = R >> 8, r = R & 255; return r < 128 ? 128 * pn + r : DFF + 128 * pn + (r - 128); }
__device__ __forceinline__ void map_win(int R, int& src, int& nv) {
    const int t = R >> 8, r = R & 255; nv = 32;
    if (t < 4) { const int base = t < 2 ? 0 : 768, tt = t & 1; src = r < 128 ? base + (4 * tt + (r >> 5)) * 64 : base + (4 * tt + ((r - 128) >> 5)) * 64 + 32; }
    else if (t == 4) { if (r < 64) src = 512 + (r >> 5) * 64; else if (r < 128) src = 640 + (r - 64); else if (r < 192) src = 512 + ((r - 128) >> 5) * 64 + 32; else src = 704 + (r - 192); }
    else if (t == 5) { if (r == 0) src = 1280; else if (r == 32) { src = 1344; nv = 8; } else if (r == 128) src = 1312; else { src = 0; nv = 0; } }
    else if (t < 10) { const int tt = t - 6; src = r < 128 ? 1352 + 128 * tt + r : 1864 + 128 * tt + (r - 128); }
    else src = 2376 + 256 * (t - 10) + r;
}
__device__ __forceinline__ void sincos_tab(double a, float& c, float& s) {
    const double k = rint(a * 0.63661977236758134308);
    double r = fma(-k, 1.57079632679489655800e+00, a); r = fma(-k, 6.12323399573676603587e-17, r);
    const int q = (int)k & 3; const double r2 = r * r;
    double sp = 1.0 / 6227020800.0; sp = sp * r2 - 1.0 / 39916800.0; sp = sp * r2 + 1.0 / 362880.0; sp = sp * r2 - 1.0 / 5040.0; sp = sp * r2 + 1.0 / 120.0; sp = sp * r2 - 1.0 / 6.0; sp = sp * r2 + 1.0; sp = sp * r;
    double cp = -1.0 / 87178291200.0; cp = cp * r2 + 1.0 / 479001600.0; cp = cp * r2 - 1.0 / 3628800.0; cp = cp * r2 + 1.0 / 40320.0; cp = cp * r2 - 1.0 / 720.0; cp = cp * r2 + 1.0 / 24.0; cp = cp * r2 - 0.5; cp = cp * r2 + 1.0;
    const double cc = (q == 0) ? cp : (q == 1) ? -sp : (q == 2) ? -cp : sp;
    const double ss = (q == 0) ? sp : (q == 1) ? cp : (q == 2) ? -sp : -cp;
    c = (float)cc; s = (float)ss;
}

template <int NK> __device__ __forceinline__ float topk_rebuild(LAS float* val, LAS unsigned short* idx, LAS unsigned* hist, int c, int lane, float tau_prev) {
    unsigned hi[NK], lo[NK]; unsigned alive = 0u, sel = 0u;
#pragma unroll
    for (int k = 0; k < NK; ++k) { const int e = lane + 64 * k; const bool ok = e < c;
        const unsigned fv = __float_as_uint(val[e]); const unsigned iv = (unsigned)idx[e];
        const unsigned uu = (fv & 0x80000000u) ? ~fv : (fv | 0x80000000u);
        hi[k] = ok ? uu : 0u; lo[k] = ok ? (0xFFFFu - iv) : 0u; alive |= ok ? (1u << k) : 0u; }
    unsigned mxk = 0u;
#pragma unroll
    for (int k = 0; k < NK; ++k) mxk = hi[k] > mxk ? hi[k] : mxk;
#pragma unroll
    for (int o = 1; o < 64; o <<= 1) { const unsigned t = (unsigned)__shfl_xor((int)mxk, o); mxk = t > mxk ? t : mxk; }
    const unsigned tb = __float_as_uint(tau_prev), lk = (tb & 0x80000000u) ? ~tb : (tb | 0x80000000u), df = mxk ^ lk;
    const int hb = df ? 31 - __builtin_clz(df) : -1;
    unsigned P_hi = hb >= 31 ? 0u : (hb < 0 ? mxk : (mxk & ~((2u << hb) - 1u))), P_lo = 0u; bool done = false;
#pragma unroll 1
    for (int b = hb; b >= 0; --b) {
        const unsigned trial = P_hi | (1u << b); int c = 0;
#pragma unroll
        for (int k = 0; k < NK; ++k) { c += __builtin_popcountll(__builtin_amdgcn_ballot_w64(hi[k] >= trial)); asm volatile("" : "+s"(c)); }
        if (c >= 256) { P_hi = trial; if (c == 256) { done = true; break; } }
    }
    if (!done) {
        int cgt = 0;
#pragma unroll
        for (int k = 0; k < NK; ++k) { cgt += __builtin_popcountll(__builtin_amdgcn_ballot_w64(hi[k] > P_hi)); asm volatile("" : "+s"(cgt)); }
#pragma unroll 1
        for (int b = 15; b >= 0; --b) {
            const unsigned trial = P_lo | (1u << b); int c = cgt;
#pragma unroll
            for (int k = 0; k < NK; ++k) { c += __builtin_popcountll(__builtin_amdgcn_ballot_w64(hi[k] == P_hi && lo[k] >= trial)); asm volatile("" : "+s"(c)); }
            if (c >= 256) { P_lo = trial; if (c == 256) break; }
        }
    }
#pragma unroll
    for (int k = 0; k < NK; ++k) if (((alive >> k) & 1u) && (hi[k] > P_hi || (hi[k] == P_hi && lo[k] >= P_lo))) sel |= 1u << k;
    unsigned mn = 0xFFFFFFFFu;
#pragma unroll
    for (int k = 0; k < NK; ++k) if ((sel >> k) & 1u) mn = hi[k] < mn ? hi[k] : mn;
#pragma unroll
    for (int o = 1; o < 64; o <<= 1) { const unsigned t = (unsigned)__shfl_xor((int)mn, o); mn = t < mn ? t : mn; }
    int base = 0;
#pragma unroll
    for (int k = 0; k < NK; ++k) { const bool b = (sel >> k) & 1u; const unsigned long long bm = __ballot(b);
        if (b) { const int pos = base + __popcll(bm & ((1ull << lane) - 1ull)); const unsigned uu = hi[k];
            val[pos] = __uint_as_float((uu & 0x80000000u) ? (uu & 0x7FFFFFFFu) : ~uu); idx[pos] = (unsigned short)(0xFFFFu - lo[k]); }
        base += __popcll(bm); }
    return __uint_as_float((mn & 0x80000000u) ? (mn & 0x7FFFFFFFu) : ~mn);
}

__device__ __forceinline__ void attn_query(int tok, int nsel, int keybase, const LAS unsigned short* sidx, LAS float* P, LAS float* INV,
                                           const bf16* Qp, const bf16* KBp, const bf16* VBp, bf16* AOp, int lane) {
    asm volatile("" : "+v"(lane));
    const int q16 = lane & 15, g4 = lane >> 4;
    bf16x8 Bq[2][2];
#pragma unroll
    for (int c = 0; c < 2; ++c)
#pragma unroll
        for (int ks = 0; ks < 2; ++ks) {
            bf16x8 z = {0, 0, 0, 0, 0, 0, 0, 0};
            if (q16 < 8 && (q16 >> 2) == c) z = *(const bf16x8*)(Qp + (size_t)tok * 512 + q16 * 64 + ks * 32 + g4 * 8);
            Bq[c][ks] = z;
        }
    float mx = -INFINITY;
#define QK_LOAD(DST, G) do { _Pragma("unroll") for (int u_ = 0; u_ < 2; ++u_) { const int slot_ = 32 * (G) + 16 * u_ + q16; const int kidx_ = slot_ < nsel ? (int)sidx[slot_] : 0; \
        const bf16* kp_ = KBp + (size_t)(keybase + kidx_) * 128 + g4 * 8; \
        DST[u_][0] = *(const bf16x8*)kp_; DST[u_][1] = *(const bf16x8*)(kp_ + 32); DST[u_][2] = *(const bf16x8*)(kp_ + 64); DST[u_][3] = *(const bf16x8*)(kp_ + 96); } } while (0)
#define QK_MMA(SRC, G) do { _Pragma("unroll") for (int u_ = 0; u_ < 2; ++u_) { const int t_ = 2 * (G) + u_; f32x4 acc_ = {0.f, 0.f, 0.f, 0.f}; \
        acc_ = __builtin_amdgcn_mfma_f32_16x16x32_bf16(SRC[u_][0], Bq[0][0], acc_, 0, 0, 0); acc_ = __builtin_amdgcn_mfma_f32_16x16x32_bf16(SRC[u_][1], Bq[0][1], acc_, 0, 0, 0); \
        acc_ = __builtin_amdgcn_mfma_f32_16x16x32_bf16(SRC[u_][2], Bq[1][0], acc_, 0, 0, 0); acc_ = __builtin_amdgcn_mfma_f32_16x16x32_bf16(SRC[u_][3], Bq[1][1], acc_, 0, 0, 0); \
        _Pragma("unroll") for (int j_ = 0; j_ < 4; ++j_) { const int sl_ = 16 * t_ + 4 * g4 + j_; const float v_ = sl_ < nsel ? acc_[j_] * 0.125f : -INFINITY; mx = fmaxf(mx, v_); if (q16 < 8) P[sl_ * 8 + q16] = v_; } } } while (0)
    {
        bf16x8 ka[2][4], kb[2][4];
        QK_LOAD(ka, 0);
#pragma unroll 1
        for (int g = 0; g < 8; g += 2) {
            QK_LOAD(kb, g + 1); QK_MMA(ka, g);
            if (g + 2 < 8) QK_LOAD(ka, g + 2);
            QK_MMA(kb, g + 1);
        }
    }
    mx = fmaxf(mx, __shfl_xor(mx, 16)); mx = fmaxf(mx, __shfl_xor(mx, 32));
    LDS_WAIT(); asm volatile("" ::: "memory");
    float sum = 0.f;
    if (q16 < 8) {
#pragma unroll 4
        for (int t = 0; t < 16; ++t)
#pragma unroll
            for (int j = 0; j < 4; ++j) { const int sl = 16 * t + 4 * g4 + j; const float e = __expf(P[sl * 8 + q16] - mx); P[sl * 8 + q16] = e; sum += e; }
    }
    sum += __shfl_xor(sum, 16); sum += __shfl_xor(sum, 32);
    if (lane < 8) INV[lane] = 1.0f / sum;
    LDS_WAIT(); asm volatile("" ::: "memory");
    const int ks = lane >> 4, sg = lane & 15, c = sg >> 3, d0 = (sg & 7) * 8;
    float o[4][8];
#pragma unroll
    for (int h = 0; h < 4; ++h)
#pragma unroll
        for (int d = 0; d < 8; ++d) o[h][d] = 0.f;
    const bf16* vbase = VBp + (size_t)keybase * 128 + c * 64 + d0;
#define PV_LOAD(DST, S0) do { const int sb_ = (S0) + 8 * ks; v4u i8_ = *(const LAS v4u*)(sidx + sb_); if (sb_ >= nsel) i8_ = (v4u){0u, 0u, 0u, 0u}; \
        const unsigned ix_[8] = {i8_.x & 0xffffu, i8_.x >> 16, i8_.y & 0xffffu, i8_.y >> 16, i8_.z & 0xffffu, i8_.z >> 16, i8_.w & 0xffffu, i8_.w >> 16}; \
        _Pragma("unroll") for (int i_ = 0; i_ < 8; ++i_) DST[i_] = *(const v4u*)(vbase + (size_t)ix_[i_] * 128); } while (0)
#define PV_FMA(SRC, S0) do { const int sb_ = (S0) + 8 * ks; \
        _Pragma("unroll") for (int i_ = 0; i_ < 8; ++i_) { const f32x4 p_ = *(const LAS f32x4*)(P + (sb_ + i_) * 8 + 4 * c); \
            const float x_[8] = {bflo(SRC[i_].x), bfhi(SRC[i_].x), bflo(SRC[i_].y), bfhi(SRC[i_].y), bflo(SRC[i_].z), bfhi(SRC[i_].z), bflo(SRC[i_].w), bfhi(SRC[i_].w)}; \
            _Pragma("unroll") for (int h_ = 0; h_ < 4; ++h_) _Pragma("unroll") for (int d_ = 0; d_ < 8; ++d_) o[h_][d_] += p_[h_] * x_[d_]; \
            if ((i_ & 3) == 3) asm volatile("" ::: "memory"); } } while (0)
    {
        v4u va[8], vb[8];
        PV_LOAD(va, 0);
#pragma unroll 1
        for (int s0 = 0; s0 < 256; s0 += 64) {
            PV_LOAD(vb, s0 + 32); PV_FMA(va, s0);
            if (s0 + 64 < 256) PV_LOAD(va, s0 + 64);
            PV_FMA(vb, s0 + 32);
        }
    }
#pragma unroll
    for (int h = 0; h < 4; ++h)
#pragma unroll
        for (int d = 0; d < 8; ++d) { float t = o[h][d]; t += __shfl_xor(t, 16); t += __shfl_xor(t, 32); o[h][d] = t; }
    if (ks == 0) {
        const f32x4 iv = *(const LAS f32x4*)(INV + 4 * c);
#pragma unroll
        for (int h = 0; h < 4; ++h) { v4u w; w.x = cvt_pk_bf16(o[h][0] * iv[h], o[h][1] * iv[h]); w.y = cvt_pk_bf16(o[h][2] * iv[h], o[h][3] * iv[h]);
            w.z = cvt_pk_bf16(o[h][4] * iv[h], o[h][5] * iv[h]); w.w = cvt_pk_bf16(o[h][6] * iv[h], o[h][7] * iv[h]);
            *(v4u*)(AOp + (size_t)tok * 512 + (4 * c + h) * 64 + d0) = w; }
    }
    LDS_WAIT(); asm volatile("" ::: "memory");
}

#define XB_TMO      128
#define XB_XCNT(j)  (256  + 64 * (j))
#define XB_XSUB(j)  (1280 + 64 * (j))
#define XB_XGEN(j)  (2304 + 64 * (j))
#define XB_TOP      3328
#define XB_TOPGEN   3392
#define XCD_BAR_WORDS 3456
#define XB_SPIN_CAP (1u << 18)

__device__ __forceinline__ unsigned xb_ld(unsigned* p)              { return __hip_atomic_load(p, __ATOMIC_RELAXED, __HIP_MEMORY_SCOPE_AGENT); }
__device__ __forceinline__ unsigned xb_add(unsigned* p, unsigned v) { return __hip_atomic_fetch_add(p, v, __ATOMIC_RELAXED, __HIP_MEMORY_SCOPE_AGENT); }
__device__ __forceinline__ unsigned xb_xcc_id() { return (unsigned)__builtin_amdgcn_s_getreg((3 << 11) | 20) & 0xFu; }
#define XB_SPIN(cond, bar) do { unsigned _sp = 0; while (cond) { __builtin_amdgcn_s_sleep(1); \
    if ((++_sp & 255u) == 0u) { if (xb_ld(&(bar)[XB_TMO])) break; if (_sp > XB_SPIN_CAP) { atomicAdd(&(bar)[XB_TMO], 1u); break; } } } } while (0)

struct XcdBarrier {
    unsigned* bar; unsigned x;
    volatile LAS unsigned* st;
};

__device__ __forceinline__ XcdBarrier xcd_barrier_post(unsigned* bar, volatile LAS unsigned* st) {
    XcdBarrier b; b.bar = bar; b.x = xb_xcc_id(); b.st = st;
    if (threadIdx.x == 0) (void)xb_add(&bar[XB_XCNT(b.x)], 1u);
    return b;
}
__device__ __forceinline__ void xcd_barrier_complete(unsigned* bar, unsigned x, unsigned& nloc, unsigned& nx) {
    const unsigned G = gridDim.x * gridDim.y * gridDim.z;
    unsigned sum, cnt, mine, sp = 0u;
    for (;;) {
        sum = 0u; cnt = 0u; mine = 0u;
#pragma unroll
        for (unsigned j = 0; j < 16; ++j) { const unsigned c = xb_ld(&bar[XB_XCNT(j)]); sum += c; cnt += (c > 0u) ? 1u : 0u; mine = (j == x) ? c : mine; }
        if (sum == G) break;
        __builtin_amdgcn_s_sleep(1);
        if ((++sp & 255u) == 0u) { if (xb_ld(&bar[XB_TMO])) break; if (sp > XB_SPIN_CAP) { atomicAdd(&bar[XB_TMO], 1u); break; } }
    }
    nloc = mine > 0u ? mine : 1u; nx = cnt > 0u ? cnt : 1u;
}

__device__ __forceinline__ void xcd_barrier(const XcdBarrier& b) {
    asm volatile("s_waitcnt vmcnt(0)" ::: "memory");
    __syncthreads();
    if (threadIdx.x == 0) {
        unsigned* bar = b.bar;
        __builtin_amdgcn_s_waitcnt(0);
        unsigned nloc = b.st[0], nx = b.st[1];
        if (nloc == 0u) { xcd_barrier_complete(bar, b.x, nloc, nx); b.st[0] = nloc; b.st[1] = nx; }
        const unsigned old = xb_add(&bar[XB_XSUB(b.x)], 1u);
        const unsigned gen = old / nloc;
        if (old + 1u == (gen + 1u) * nloc) {
            __builtin_amdgcn_fence(__ATOMIC_RELEASE, "agent");
            asm volatile("s_waitcnt vmcnt(0)" ::: "memory");
            const unsigned og = xb_add(&bar[XB_TOP], 1u);
            const unsigned tg = og / nx;
            if (og + 1u == (tg + 1u) * nx) xb_add(&bar[XB_TOPGEN], 1u);
            else XB_SPIN(xb_ld(&bar[XB_TOPGEN]) == tg, bar);
            __builtin_amdgcn_fence(__ATOMIC_ACQUIRE, "agent");
            xb_add(&bar[XB_XGEN(b.x)], 1u);
            asm volatile("s_waitcnt vmcnt(0)" ::: "memory");
        } else {
            XB_SPIN(xb_ld(&bar[XB_XGEN(b.x)]) == gen, bar);
            __builtin_amdgcn_fence(__ATOMIC_ACQUIRE, "agent");
            asm volatile("s_waitcnt vmcnt(0)" ::: "memory");
        }
    }
    __syncthreads();
}

#ifdef TSEL
#define TSTAMP() do { if (bx == 0 && tid == 0) { ((volatile LAS unsigned long long*)(lds + 131072 + 1024))[ts_n] = __builtin_amdgcn_s_memrealtime(); } ++ts_n; } while (0)
#else
#define TSTAMP() do {} while (0)
#endif
#define LBAR() do { asm volatile("s_waitcnt lgkmcnt(0)" ::: "memory"); __builtin_amdgcn_s_barrier(); asm volatile("" ::: "memory"); } while (0)
#define GSYNC() do { grid.sync(); TSTAMP(); } while (0)
#define XSYNC() do { xcd_barrier(xbar); TSTAMP(); } while (0)
#define LSYNC() do { asm volatile("s_waitcnt vmcnt(0)" ::: "memory"); __syncthreads(); ++ls_ep; \
    if (tid == 0) { unsigned* cp_ = CTL + 5120 + 64 * xcc; __hip_atomic_fetch_add(cp_, 1u, __ATOMIC_RELAXED, __HIP_MEMORY_SCOPE_AGENT); \
        const unsigned want_ = (unsigned)ls_ep * (unsigned)x_nloc; unsigned sp_ = 0u; \
        while (__hip_atomic_load(cp_, __ATOMIC_RELAXED, __HIP_MEMORY_SCOPE_AGENT) < want_) { __builtin_amdgcn_s_sleep(2); if (++sp_ > (1u << 22)) break; } \
        __builtin_amdgcn_fence(__ATOMIC_ACQUIRE, "agent"); asm volatile("s_waitcnt vmcnt(0)" ::: "memory"); } \
    __syncthreads(); TSTAMP(); } while (0)
#ifndef PHMASK
#define PHMASK 0x3ff
#endif
__global__ void __launch_bounds__(512, 2) mega_fwd(Args args) {
    extern __shared__ __attribute__((aligned(16))) unsigned char lds_raw[];
    cg::grid_group grid = cg::this_grid();
    LAS unsigned char* lds = (LAS unsigned char*)lds_raw;
    const int tid = threadIdx.x, lane = tid & 63, wave = __builtin_amdgcn_readfirstlane(tid >> 6);
    const int G = gridDim.x, bx = blockIdx.x;
    const int gw = bx * NWAVES + wave, NGW = G * NWAVES;
    volatile LAS int* XW = (volatile LAS int*)(lds + 131072 + 64);
    const unsigned xcc = (unsigned)__builtin_amdgcn_s_getreg((3 << 11) | 20) & 0xFu;
    int ts_n = 0; TSTAMP();
    if (tid < 2) XW[56 + tid] = 0;
    __syncthreads();
    grid.sync();
    const XcdBarrier xbar = xcd_barrier_post((unsigned*)(args.ws + WS_CTL) + 12288, (volatile LAS unsigned*)(lds + 131072 + 64 + 56 * 4));
    int ls_ep = 0;
#ifdef P4PROBE
    if (tid == 0) { volatile LAS unsigned long long* TS = (volatile LAS unsigned long long*)(lds + 131072 + 1024); TS[40] = 0; TS[41] = 0; TS[42] = 0; TS[43] = 0; }
#endif
    if (tid == 0) XW[0] = (int)__hip_atomic_fetch_add((unsigned*)(args.ws + WS_CTL) + 1024 + 64 * xcc, 1u, __ATOMIC_RELAXED, __HIP_MEMORY_SCOPE_AGENT);
#define ws (args.ws)
#define out (args.out)
#define xP (args.in[0])
#define xS (args.in[1])
#define W1T ((bf16*)(ws + WS_W1T))
#define W1OT ((bf16*)(ws + WS_W1OT))
#define WINT ((bf16*)(ws + WS_WINT))
#define WCOT ((bf16*)(ws + WS_WCOT))
#define WAOT ((bf16*)(ws + WS_WAOT))
#define WOT ((bf16*)(ws + WS_WOT))
#define W2T ((bf16*)(ws + WS_W2T))
#define W2OT ((bf16*)(ws + WS_W2OT))
#define XB ((bf16*)(ws + WS_XB))
#define ACT ((bf16*)(ws + WS_ACT))
#define GATE ((bf16*)(ws + WS_GATE))
#define CB ((bf16*)(ws + WS_ACT) + 2048)
#define QB ((bf16*)(ws + WS_Q))
#define QIB ((unsigned short*)(ws + WS_QI))
#define MG ((bf16*)(ws + WS_MERGED))
#define KB ((bf16*)(ws + WS_KB))
#define VB ((bf16*)(ws + WS_VB))
#define KIB ((unsigned short*)(ws + WS_KIB))
#define AO ((bf16*)(ws + WS_AO))
#define CA ((bf16*)(ws + WS_CA))
#define RSTD0 ((float*)(ws + WS_RSTD0))
#define WI ((float*)(ws + WS_WI))
#define SSQ1 ((float*)(ws + WS_SSQ1))
#define SSQ2 ((float*)(ws + WS_SSQ2))
#define SSQ3 ((float*)(ws + WS_SSQ3))
#define COST ((float*)(ws + WS_COS))
#define SINT ((float*)(ws + WS_SIN))
#define CTL ((unsigned*)(ws + WS_CTL))
#define H (out + O_Y)

    if (PHMASK & (1 << 0)) {
        LAS float* scr = (LAS float*)(lds + wave * 16384);
        if (bx == 0 && tid < 16) { CTL[2048 + 64 * tid] = 0u; CTL[3072 + 64 * tid] = 0u; }
        constexpr int I_W1 = 16 * 176, I_W1O = 44 * 32, I_WIN = 16 * 144, I_WCO = 8 * 32, I_WAO = 8 * 32, I_WO = 16 * 32, I_W2 = I_W1, I_W2O = I_W1O;
        constexpr int NIT = I_W1 + I_W1O + I_WIN + I_WCO + I_WAO + I_WO + I_W2 + I_W2O;
        for (int it = gw; it < NIT; it += NGW) {
            int r = it;
            if (r < I_W1) { const int kb = r / 176, g = r % 176; p0_transpose_item(args.in[7], 1024, 2 * DFF, W1T, map_swiglu(32 * g), 32, 32 * g, args.in[6], kb, scr, lane); continue; } r -= I_W1;
            if (r < I_W1O) { const int kb = r / 32, g = r % 32; p0_transpose_item(args.in[8], DFF, 1024, W1OT, 32 * g, 32, 32 * g, nullptr, kb, scr, lane); continue; } r -= I_W1O;
            if (r < I_WIN) { const int kb = r / 144, g = r % 144; int src, nv; map_win(32 * g, src, nv); p0_transpose_item(args.in[10], 1024, 4424, WINT, src, nv, 32 * g, args.in[9], kb, scr, lane); continue; } r -= I_WIN;
            if (r < I_WCO) { const int kb = r / 32, g = r % 32; p0_transpose_item(args.in[16], 512, 1024, WCOT, 32 * g, 32, 32 * g, nullptr, kb, scr, lane); continue; } r -= I_WCO;
            if (r < I_WAO) { const int kb = r / 32, g = r % 32; p0_transpose_item(args.in[17], 512, 1024, WAOT, 32 * g, 32, 32 * g, nullptr, kb, scr, lane); continue; } r -= I_WAO;
            if (r < I_WO) { const int kb = r / 32, g = r % 32; p0_transpose_item(args.in[18], 1024, 1024, WOT, 32 * g, 32, 32 * g, nullptr, kb, scr, lane); continue; } r -= I_WO;
            if (r < I_W2) { const int kb = r / 176, g = r % 176; p0_transpose_item(args.in[20], 1024, 2 * DFF, W2T, map_swiglu(32 * g), 32, 32 * g, args.in[19], kb, scr, lane); continue; } r -= I_W2;
            { const int kb = r / 32, g = r % 32; p0_transpose_item(args.in[21], DFF, 1024, W2OT, 32 * g, 32, 32 * g, nullptr, kb, scr, lane); }
        }
        for (int row0 = gw; row0 < NTOK; row0 += 3 * NGW) {
            f32x4 v[3][4];
#pragma unroll
            for (int q = 0; q < 3; ++q) { const int row = row0 + q * NGW;
                if (row < NTOK) { const float* xr = row < NPR ? xP + (size_t)row * DM : xS + (size_t)(row - NPR) * DM;
#pragma unroll
                    for (int j = 0; j < 4; ++j) v[q][j] = *(const f32x4*)(xr + 4 * lane + 256 * j); } }
#pragma unroll
            for (int q = 0; q < 3; ++q) { const int row = row0 + q * NGW;
                if (row < NTOK) { float ss = 0.f;
#pragma unroll
                    for (int j = 0; j < 4; ++j) ss += (v[q][j].x * v[q][j].x + v[q][j].y * v[q][j].y) + (v[q][j].z * v[q][j].z + v[q][j].w * v[q][j].w);
                    ss = wave_sum(ss);
                    if (lane == 0) RSTD0[row] = 1.0f / sqrtf(ss * (1.0f / 1024.0f) + EPS);
#pragma unroll
                    for (int j = 0; j < 4; ++j) { v2u w; w.x = pk2(v[q][j].x, v[q][j].y); w.y = pk2(v[q][j].z, v[q][j].w); *(v2u*)(XB + (size_t)row * DM + 4 * lane + 256 * j) = w; } } }
        }
        for (int ch0 = gw; ch0 < 40960; ch0 += 4 * NGW) {
            f32x4 cv[4];
#pragma unroll
            for (int q = 0; q < 4; ++q) { const int ch = ch0 + q * NGW;
                if (ch < 40960) { const float* src = ch < 16384 ? args.in[2] + (size_t)ch * 256 : (ch < 32768 ? args.in[3] + (size_t)(ch - 16384) * 256 : args.in[4] + (size_t)(ch - 32768) * 256);
                    cv[q] = *(const f32x4*)(src + 4 * lane); } }
#pragma unroll
            for (int q = 0; q < 4; ++q) { const int ch = ch0 + q * NGW;
                if (ch < 40960) { const f32x4 v = cv[q];
                    if (ch < 32768) { const bool isv = ch >= 16384; const int e = (isv ? ch - 16384 : ch) * 256 + 4 * lane; const int b = e >> 17, rem = e & 131071;
                        v2u w; w.x = pk2(v.x, v.y); w.y = pk2(v.z, v.w); *(v2u*)((isv ? VB : KB) + (size_t)(NPR + b * LSM) * 128 + rem) = w; }
                    else { const int e = (ch - 32768) * 256 + 4 * lane; const int b = e >> 16, rem = e & 65535;
                        v2u w; w.x = pkh(v.x, v.y); w.y = pkh(v.z, v.w); *(v2u*)(KIB + (size_t)(NPR + b * LSM) * 64 + rem) = w; } } }
        }
        for (int e = bx * 512 + tid; e < TPR * 32; e += G * 512) { float c, s; sincos_tab((double)(e >> 5) * args.invf[e & 31], c, s); COST[e] = c; SINT[e] = s; }
    }
    XSYNC();
    if (tid == 0) {
        int nx = 0, xi = 0, nloc = 1;
        for (int j = 0; j < 16; ++j) { const int c = (int)__hip_atomic_load(CTL + 1024 + 64 * j, __ATOMIC_RELAXED, __HIP_MEMORY_SCOPE_AGENT);
            if (c > 0) { if (j == (int)xcc) { xi = nx; nloc = c; } ++nx; } }
        XW[1] = nx > 0 ? nx : 1; XW[2] = xi; XW[3] = nloc;
    }
    __syncthreads();
    const int x_r = __builtin_amdgcn_readfirstlane(XW[0]), x_nx = __builtin_amdgcn_readfirstlane(XW[1]), x_xi = __builtin_amdgcn_readfirstlane(XW[2]), x_nloc = __builtin_amdgcn_readfirstlane(XW[3]);
    const int x_T = x_nx == 8 ? 9 : (72 - x_xi + x_nx - 1) / x_nx;

    if (PHMASK & (1 << 1)) {
        pg8::Gemm g{XB, W1T, XB, W1T, NTOK, 2 * DFF, 1024}; pg8::XcdOrder S; S.init(NTOK, 2 * DFF, 1024, x_xi, x_nx, x_nloc, x_r, 0, 0);
        EpiSwiglu E{ACT, RSTD0, nullptr};
        pg8::gemm_phase<EpiSwiglu, pg8::XcdOrder, true, true>(lds, g, S, E);
    }
    LSYNC();
    if (PHMASK & (1 << 2)) {
        pg8::Gemm g{ACT, W1OT, ACT, W1OT, NTOK, 1024, DFF}; pg8::XcdOrder S; S.init(NTOK, 1024, DFF, x_xi, x_nx, x_nloc, x_r, 0, 1);
        EpiResid E{xP, xS, H, XB, SSQ1, 0.5f, QB};
        pg8::gemm_phase<EpiResid, pg8::XcdOrder, true, true>(lds, g, S, E);
    }
    LSYNC();
    if (x_nx == 8) {
        for (int jr = x_r * NWAVES + wave; jr < 256; jr += x_nloc * NWAVES) {
            const int row = pg8::xcd_tile(x_xi, x_nx, x_T - 1) * 256 + jr;
            float* hr = H + (size_t)row * DM; f32x4 v[4]; float ss = 0.f;
#pragma unroll
            for (int j = 0; j < 4; ++j) { v[j] = *(const f32x4*)((xS + (size_t)(row - NPR) * DM) + 4 * lane + 256 * j);
                f32x4 sm = {0.f, 0.f, 0.f, 0.f};
#pragma unroll
                for (int c = 0; c < 8; ++c) { const v2u pw = *(const v2u*)(QB + ((size_t)((row >> 8) - 64) * 8 + c) * 256 * DM + (size_t)(row & 255) * DM + 4 * lane + 256 * j);
                    sm.x += bflo(pw.x); sm.y += bfhi(pw.x); sm.z += bflo(pw.y); sm.w += bfhi(pw.y); }
                v[j] = v[j] + sm * 0.5f; *(f32x4*)(hr + 4 * lane + 256 * j) = v[j]; ss += (v[j].x * v[j].x + v[j].y * v[j].y) + (v[j].z * v[j].z + v[j].w * v[j].w); }
            ss = wave_sum(ss);
            if (lane < 16) SSQ1[(size_t)row * 16 + lane] = lane == 0 ? ss : 0.f;
            if (lane == 0) RSTD0[row] = 1.0f / sqrtf(ss * (1.0f / 1024.0f) + EPS);
#pragma unroll
            for (int j = 0; j < 4; ++j) { v2u w; w.x = pk2(v[j].x, v[j].y); w.y = pk2(v[j].z, v[j].w); *(v2u*)(XB + (size_t)row * DM + 4 * lane + 256 * j) = w; }
        }
        for (int jr = (x_r * NWAVES + wave) * 64 + lane; jr < (x_T - 1) * 256; jr += x_nloc * NWAVES * 64) {
            const int row = pg8::xcd_tile(x_xi, x_nx, jr >> 8) * 256 + (jr & 255);
            RSTD0[row] = row_rstd16(SSQ1, row);
        }
        XSYNC();
    }
    else { for (int jr = (x_r * NWAVES + wave) * 64 + lane; jr < x_T * 256; jr += x_nloc * NWAVES * 64) { const int row = pg8::xcd_tile(x_xi, x_nx, jr >> 8) * 256 + (jr & 255); RSTD0[row] = row_rstd16(SSQ1, row); }
        XSYNC(); }
    if (PHMASK & (1 << 3)) {
        pg8::Gemm g{XB, WINT, XB, WINT, NTOK, NIN, 1024}; pg8::XcdOrder S; S.init(NTOK, NIN, 1024, x_xi, x_nx, x_nloc, x_r, 0, 0);
        EpiMix E{RSTD0, COST, SINT, args.in[11], QB, QIB, KB, VB, KIB, WI, CB, GATE, out, ws};
        pg8::gemm_phase<EpiMix, pg8::XcdOrder, true, true>(lds, g, S, E);
    }
    XSYNC();
    if (PHMASK & (1 << 4)) {
        LAS float* cval = (LAS float*)(lds + L_VAL); LAS unsigned short* cidx = (LAS unsigned short*)(lds + L_IDX);
        LAS unsigned* hist = (LAS unsigned*)(lds + L_HIST) + wave * 16;
        volatile LAS unsigned* cnt = (volatile LAS unsigned*)(lds + L_CNT); volatile LAS float* tau = (volatile LAS float*)(lds + L_TAU);
        volatile LAS int* itemw = (volatile LAS int*)(lds + L_ITEM);
        const int q16 = lane & 15, g4 = lane >> 4;
        const int N_ATT = x_T * 16, N_CONV = x_T * 4;
        if (tid == 0) {
            for (int t = 0; t < 16; ++t) { XW[16 + t] = 0; XW[32 + t] = -1; }
            for (int t = 0; t < x_T && t < 16; ++t) { const int pm = pg8::xcd_tile(x_xi, x_nx, t); XW[16 + t] = pm; XW[32 + t] = pm < 64 ? 8 * (pm & 31) + 7 : 33; }
            for (int a = 0; a < 16; ++a) { int best = a; for (int b2 = a + 1; b2 < 16; ++b2) if (XW[32 + b2] > XW[32 + best]) best = b2;
                const int tk = XW[32 + a], tt = XW[16 + a]; XW[32 + a] = XW[32 + best]; XW[16 + a] = XW[16 + best]; XW[32 + best] = tk; XW[16 + best] = tt; }
        }
        for (;;) {
            __syncthreads();
            if (tid == 0) *itemw = (int)atomicAdd(CTL + 2048 + 64 * x_xi, 1u);
            __syncthreads();
            const int item = *itemw;
            if (item >= N_ATT) break;
#ifdef P4PROBE
            const unsigned long long pt0 = __builtin_amdgcn_s_memrealtime();
#endif
            {
                int tok0, N, keybase;
                { const int tile = XW[16 + (item >> 4)], sub = item & 15;
                  if (tile < 64) { const int b = tile >> 5, cl = 3 - (sub >> 2), c = (tile & 31) * 4 + cl, qq = sub & 3; tok0 = tile * 256 + cl * 64 + qq * 16; N = 64 * (c + 1); keybase = b * TPR; }
                  else { tok0 = tile * 256 + sub * 16; const int b = (tok0 - NPR) >> 6; N = LSM; keybase = NPR + b * LSM; } }
                if (N > 256) {
                    if (tid < 16) { cnt[tid] = 0u; tau[tid] = -INFINITY; }
                    if (tid == 0) XW[48] = 0;
                    h16x8 Bq[8][2];
#pragma unroll
                    for (int h = 0; h < 8; ++h)
#pragma unroll
                        for (int ks = 0; ks < 2; ++ks) Bq[h][ks] = *(const h16x8*)(QIB + (size_t)(tok0 + q16) * 512 + h * 64 + ks * 32 + g4 * 8);
                    const f32x4 w0 = *(const f32x4*)(WI + (size_t)(tok0 + q16) * 8), w1 = *(const f32x4*)(WI + (size_t)(tok0 + q16) * 8 + 4);
                    const float wq[8] = {w0.x, w0.y, w0.z, w0.w, w1.x, w1.y, w1.z, w1.w};
                    __syncthreads();
                    const int nrounds = (N + 511) >> 9;
#define LOAD_KI(DST, SEG) do { _Pragma("unroll") for (int t_ = 0; t_ < 4; ++t_) { const unsigned short* kp_ = KIB + (size_t)(keybase + (SEG) + 16 * t_ + q16) * 64 + g4 * 8; \
        DST[t_][0] = *(const h16x8*)kp_; DST[t_][1] = *(const h16x8*)(kp_ + 32); } } while (0)
                    h16x8 An[4][2];
#pragma unroll
                    for (int t = 0; t < 4; ++t) { An[t][0] = (h16x8){0, 0, 0, 0, 0, 0, 0, 0}; An[t][1] = An[t][0]; }
                    if (wave * 64 < N) LOAD_KI(An, wave * 64);
                    for (int r = 0; r < nrounds; ++r) {
#ifdef P4PROBE3
                        const unsigned long long rc0 = __builtin_amdgcn_s_memrealtime();
#endif
                        const int seg = r * 512 + wave * 64;
                        const float tq = tau[q16];
                        if (seg < N) {
#pragma unroll
                            for (int t = 0; t < 4; ++t) {
                                const int key0 = seg + 16 * t;
                                f32x4 sc = {0.f, 0.f, 0.f, 0.f};
#pragma unroll
                                for (int h = 0; h < 8; ++h) {
                                    f32x4 acc = {0.f, 0.f, 0.f, 0.f};
                                    acc = __builtin_amdgcn_mfma_f32_16x16x32_f16(An[t][0], Bq[h][0], acc, 0, 0, 0);
                                    acc = __builtin_amdgcn_mfma_f32_16x16x32_f16(An[t][1], Bq[h][1], acc, 0, 0, 0);
#pragma unroll
                                    for (int j = 0; j < 4; ++j) sc[j] += wq[h] * fmaxf(acc[j], 0.f);
                                }
#pragma unroll
                                for (int j = 0; j < 4; ++j) if (sc[j] > tq) {
                                    const unsigned pos = atomicAdd((unsigned*)(cnt + q16), 1u);
                                    cval[q16 * CAPS + pos] = sc[j]; cidx[q16 * CAPS + pos] = (unsigned short)(key0 + 4 * g4 + j);
                                }
                            }
                            if (seg + 512 < N) LOAD_KI(An, seg + 512);
                        }
                        LBAR();
#ifdef P4PROBE2
                        const unsigned long long rb0 = __builtin_amdgcn_s_memrealtime();
#endif
                        const bool last = (r == nrounds - 1);
                        bool trig = last;
                        { const volatile LAS v4u* cq = (const volatile LAS v4u*)(lds + L_CNT);
#pragma unroll
                          for (int i4 = 0; i4 < 4; ++i4) { const v4u cc = cq[i4]; trig = trig || cc.x > (unsigned)(CAP - 512) || cc.y > (unsigned)(CAP - 512) || cc.z > (unsigned)(CAP - 512) || cc.w > (unsigned)(CAP - 512); } }
                        if (trig) {
#pragma unroll 1
                            for (int k = 0; k < 2; ++k) { const int qq = 2 * wave + k; const int c = (int)cnt[qq];
                                if (c > 256) { const float t = c <= 512 ? topk_rebuild<8>(cval + qq * CAPS, cidx + qq * CAPS, hist, c, lane, tau[qq]) : (c <= 1024 ? topk_rebuild<16>(cval + qq * CAPS, cidx + qq * CAPS, hist, c, lane, tau[qq]) : topk_rebuild<20>(cval + qq * CAPS, cidx + qq * CAPS, hist, c, lane, tau[qq])); if (lane == 0) { cnt[qq] = 256u; tau[qq] = t; } } }
                        }
                        LBAR();
#ifdef P4PROBE2
                        { const unsigned long long rb1 = __builtin_amdgcn_s_memrealtime(); if (bx == 0 && tid == 0) { volatile LAS unsigned long long* TS = (volatile LAS unsigned long long*)(lds + 131072 + 1024); TS[42] += rb1 - rb0; TS[43] += 1; } }
#endif
                    }
                } else {
                    for (int i = tid; i < 16 * 256; i += 512) cidx[(i >> 8) * CAPS + (i & 255)] = (unsigned short)(i & 255);
                    __syncthreads();
                }
                const int nsel = N < 256 ? N : 256;
#ifdef P4PROBE
                const unsigned long long pt1 = __builtin_amdgcn_s_memrealtime();
#endif
#pragma unroll 1
                for (int k = 0; k < 2; ++k) { const int qq = 2 * wave + k;
#ifndef NO_ATTNQ
                    attn_query(tok0 + qq, nsel, keybase, cidx + qq * CAPS, (LAS float*)(lds + L_VAL) + wave * 2 * CAPS, (LAS float*)hist, QB, KB, VB, AO, lane);
#endif
 }
#ifdef P4PROBE
                __syncthreads(); { const unsigned long long pt2 = __builtin_amdgcn_s_memrealtime(); if (bx == 0 && tid == 0) { volatile LAS unsigned long long* TS = (volatile LAS unsigned long long*)(lds + 131072 + 1024); TS[40] += pt1 - pt0; TS[41] += pt2 - pt1; } }
#endif
            }
        }
        for (;;) {
            __syncthreads();
            if (tid == 0) *itemw = (int)atomicAdd(CTL + 3072 + 64 * x_xi, 1u);
            __syncthreads();
            const int item = *itemw;
            if (item >= N_CONV) break;
            {
                const int tok0 = pg8::xcd_tile(x_xi, x_nx, item >> 2) * 256 + (item & 3) * 64;
                __syncthreads();
                for (int i = tid; i < 31 * 512 / 4; i += 512) ((LAS f32x4*)lds)[i] = ((const f32x4*)args.in[12])[i];
                __syncthreads();
                const int ch = 8 * lane;
                const f32x4 cb0 = *(const f32x4*)(args.in[13] + ch), cb1 = *(const f32x4*)(args.in[13] + ch + 4);
                const f32x4 lg0 = *(const f32x4*)(args.in[14] + ch), lg1 = *(const f32x4*)(args.in[14] + ch + 4);
                const f32x4 lb0 = *(const f32x4*)(args.in[15] + ch), lb1 = *(const f32x4*)(args.in[15] + ch + 4);
                const int t0 = tok0 + wave * 8;
                const bool smp = t0 >= NPR; const int sb = (t0 - NPR) >> 6; const int j0 = smp ? ((t0 - NPR) & 63) : (t0 & (TPR - 1));
                float acc[8][8];
#pragma unroll
                for (int t = 0; t < 8; ++t) { acc[t][0] = cb0.x; acc[t][1] = cb0.y; acc[t][2] = cb0.z; acc[t][3] = cb0.w; acc[t][4] = cb1.x; acc[t][5] = cb1.y; acc[t][6] = cb1.z; acc[t][7] = cb1.w; }
#pragma unroll 2
                for (int rr = 0; rr < 38; ++rr) {
                    const int jr = j0 - 30 + rr;
                    float x[8];
                    if (jr >= 0) { const int st = t0 - 30 + rr; const bf16* xp = CB + (size_t)st * DFF + ch;
                        if ((st >> 8) != (t0 >> 8)) { const int p = st >> 8; xp = (const bf16*)(ws + ((p >> 5) ? WS_HALO_B : WS_HALO_A)) + (size_t)((p & 31) * 30 + (st & 255) - 226) * 512 + ch; }
                        const v4u xv = *(const v4u*)xp;
                        x[0] = bflo(xv.x); x[1] = bfhi(xv.x); x[2] = bflo(xv.y); x[3] = bfhi(xv.y); x[4] = bflo(xv.z); x[5] = bfhi(xv.z); x[6] = bflo(xv.w); x[7] = bfhi(xv.w); }
                    else if (smp) { const float* sp = args.in[5] + (size_t)(sb * 30 + 30 + jr) * 512 + ch; const f32x4 s0 = *(const f32x4*)sp, s1 = *(const f32x4*)(sp + 4);
                        x[0] = s0.x; x[1] = s0.y; x[2] = s0.z; x[3] = s0.w; x[4] = s1.x; x[5] = s1.y; x[6] = s1.z; x[7] = s1.w; }
                    else continue;
#pragma unroll
                    for (int t = 0; t < 8; ++t) { const int w = rr - t;
                        if (w >= 0 && w <= 30) {
                            const f32x4 k0 = *(const LAS f32x4*)(lds + (size_t)(w * 512 + ch) * 4), k1 = *(const LAS f32x4*)(lds + (size_t)(w * 512 + ch + 4) * 4);
                            acc[t][0] += x[0] * k0.x; acc[t][1] += x[1] * k0.y; acc[t][2] += x[2] * k0.z; acc[t][3] += x[3] * k0.w;
                            acc[t][4] += x[4] * k1.x; acc[t][5] += x[5] * k1.y; acc[t][6] += x[6] * k1.z; acc[t][7] += x[7] * k1.w; } }
                }
                const float gg[8] = {lg0.x, lg0.y, lg0.z, lg0.w, lg1.x, lg1.y, lg1.z, lg1.w}, bb[8] = {lb0.x, lb0.y, lb0.z, lb0.w, lb1.x, lb1.y, lb1.z, lb1.w};
#pragma unroll
                for (int t = 0; t < 8; ++t) {
                    float a[8];
#pragma unroll
                    for (int i = 0; i < 8; ++i) a[i] = acc[t][i];
                    float s_ = ((a[0] + a[1]) + (a[2] + a[3])) + ((a[4] + a[5]) + (a[6] + a[7]));
                    const float mean = wave_sum(s_) * (1.0f / 512.0f);
                    float q = 0.f;
#pragma unroll
                    for (int i = 0; i < 8; ++i) { a[i] -= mean; q += a[i] * a[i]; }
                    const float rs = 1.0f / sqrtf(wave_sum(q) * (1.0f / 512.0f) + EPS);
#pragma unroll
                    for (int i = 0; i < 8; ++i) a[i] = siluf_(a[i] * rs * gg[i] + bb[i]);
                    v4u o; o.x = cvt_pk_bf16(a[0], a[1]); o.y = cvt_pk_bf16(a[2], a[3]); o.z = cvt_pk_bf16(a[4], a[5]); o.w = cvt_pk_bf16(a[6], a[7]);
                    *(v4u*)(CA + (size_t)(t0 + t) * 512 + ch) = o;
                }
            }
        }
    }
    XSYNC();
    if (PHMASK & (1 << 5)) {
        pg8::Gemm g{AO, WAOT, CA, WCOT, NTOK, 1024, 512}; pg8::XcdOrder S; S.init(NTOK, 1024, 512, x_xi, x_nx, x_nloc, x_r, 1, 0);
        EpiMerge E{GATE, MG};
        pg8::gemm_phase<EpiMerge, pg8::XcdOrder, true, true>(lds, g, S, E);
    }
    XSYNC();
    if (PHMASK & (1 << 6)) {
        pg8::Gemm g{MG, WOT, MG, WOT, NTOK, 1024, 1024}; pg8::XcdOrder S; S.init(NTOK, 1024, 1024, x_xi, x_nx, x_nloc, x_r, 0, 1);
        EpiResid E{H, H + (size_t)NPR * DM, H, XB, SSQ2, 1.0f, KB};
        pg8::gemm_phase<EpiResid, pg8::XcdOrder, true, true>(lds, g, S, E);
    }
    LSYNC();
    if (x_nx == 8) {
        for (int jr = x_r * NWAVES + wave; jr < 256; jr += x_nloc * NWAVES) {
            const int row = pg8::xcd_tile(x_xi, x_nx, x_T - 1) * 256 + jr;
            float* hr = H + (size_t)row * DM; f32x4 v[4]; float ss = 0.f;
#pragma unroll
            for (int j = 0; j < 4; ++j) { v[j] = *(const f32x4*)(hr + 4 * lane + 256 * j);
                f32x4 sm = {0.f, 0.f, 0.f, 0.f};
#pragma unroll
                for (int c = 0; c < 4; ++c) { const v2u pw = *(const v2u*)(KB + ((size_t)((row >> 8) - 64) * 8 + c) * 256 * DM + (size_t)(row & 255) * DM + 4 * lane + 256 * j);
                    sm.x += bflo(pw.x); sm.y += bfhi(pw.x); sm.z += bflo(pw.y); sm.w += bfhi(pw.y); }
                v[j] = v[j] + sm * 1.0f; *(f32x4*)(hr + 4 * lane + 256 * j) = v[j]; ss += (v[j].x * v[j].x + v[j].y * v[j].y) + (v[j].z * v[j].z + v[j].w * v[j].w); }
            ss = wave_sum(ss);
            if (lane < 16) SSQ2[(size_t)row * 16 + lane] = lane == 0 ? ss : 0.f;
            if (lane == 0) RSTD0[row] = 1.0f / sqrtf(ss * (1.0f / 1024.0f) + EPS);
#pragma unroll
            for (int j = 0; j < 4; ++j) { v2u w; w.x = pk2(v[j].x, v[j].y); w.y = pk2(v[j].z, v[j].w); *(v2u*)(XB + (size_t)row * DM + 4 * lane + 256 * j) = w; }
        }
        for (int jr = (x_r * NWAVES + wave) * 64 + lane; jr < (x_T - 1) * 256; jr += x_nloc * NWAVES * 64) {
            const int row = pg8::xcd_tile(x_xi, x_nx, jr >> 8) * 256 + (jr & 255);
            RSTD0[row] = row_rstd16(SSQ2, row);
        }
        LSYNC();
    }
    else { for (int jr = (x_r * NWAVES + wave) * 64 + lane; jr < x_T * 256; jr += x_nloc * NWAVES * 64) { const int row = pg8::xcd_tile(x_xi, x_nx, jr >> 8) * 256 + (jr & 255); RSTD0[row] = row_rstd16(SSQ2, row); }
        LSYNC(); }
    if (PHMASK & (1 << 7)) {
        pg8::Gemm g{XB, W2T, XB, W2T, NTOK, 2 * DFF, 1024}; pg8::XcdOrder S; S.init(NTOK, 2 * DFF, 1024, x_xi, x_nx, x_nloc, x_r, 0, 0);
        EpiSwiglu E{ACT, RSTD0, nullptr};
        pg8::gemm_phase<EpiSwiglu, pg8::XcdOrder, true, true>(lds, g, S, E);
    }
    LSYNC();
    if (PHMASK & (1 << 8)) {
        pg8::Gemm g{ACT, W2OT, ACT, W2OT, NTOK, 1024, DFF}; pg8::XcdOrder S; S.init(NTOK, 1024, DFF, x_xi, x_nx, x_nloc, x_r, 0, 1);
        EpiResidNorm E{H, SSQ3, KB, args.in[22], CTL + 7168, (x_nx == 8 && x_nloc == 32) ? 1 : 0};
        pg8::gemm_phase<EpiResidNorm, pg8::XcdOrder, true, true>(lds, g, S, E);
    }
    LSYNC();
#ifdef TSEL
    float tsD = 0.f;
    { volatile LAS unsigned long long* TS = (volatile LAS unsigned long long*)(lds + 131072 + 1024);
      if (bx == 0 && tid == 0) {
#ifdef P4PROBE
#if defined(P4PROBE2) || defined(P4PROBE3)
        const float us = (float)TS[42] * 0.01f, us2 = (float)TS[43] * 1.0f;
#else
        const float us = (float)TS[40] * 0.01f, us2 = (float)TS[41] * 0.01f;
#endif
#else
        const float us = (float)(TS[TSEL + 1] - TS[TSEL]) * 0.01f, us2 = (float)(TS[TSEL2 + 1] - TS[TSEL2]) * 0.01f;
#endif

        __hip_atomic_store((float*)(CTL + 8000), 8.0f + us * 0.01f, __ATOMIC_RELAXED, __HIP_MEMORY_SCOPE_AGENT); __hip_atomic_store((float*)(CTL + 8001), us2 * 0.02f, __ATOMIC_RELAXED, __HIP_MEMORY_SCOPE_AGENT); } }
    GSYNC();
    tsD = __hip_atomic_load((float*)(CTL + 8000), __ATOMIC_RELAXED, __HIP_MEMORY_SCOPE_AGENT); const float tsD2 = __hip_atomic_load((float*)(CTL + 8001), __ATOMIC_RELAXED, __HIP_MEMORY_SCOPE_AGENT);
#endif
    const int p9_lo = (x_nx == 8 && x_nloc == 32) ? (x_T - 1) * 256 : 0;
    if (PHMASK & (1 << 9)) for (int jr = p9_lo + x_r * NWAVES + wave; jr < x_T * 256; jr += x_nloc * NWAVES) {
        const int row = pg8::xcd_tile(x_xi, x_nx, jr >> 8) * 256 + (jr & 255);
        float* hr = H + (size_t)row * DM; f32x4 hv[4]; float ss9 = 0.f;
#pragma unroll
        for (int j = 0; j < 4; ++j) { hv[j] = *(const f32x4*)(hr + 4 * lane + 256 * j);
            if (x_nx == 8 && row >= NPR) { f32x4 sm = {0.f, 0.f, 0.f, 0.f};
#pragma unroll
                for (int c = 0; c < 8; ++c) { const v2u pw = *(const v2u*)(KB + ((size_t)((row >> 8) - 64) * 8 + c) * 256 * DM + (size_t)(row & 255) * DM + 4 * lane + 256 * j);
                    sm.x += bflo(pw.x); sm.y += bfhi(pw.x); sm.z += bflo(pw.y); sm.w += bfhi(pw.y); }
                hv[j] = hv[j] + sm * 0.5f; }
            ss9 += (hv[j].x * hv[j].x + hv[j].y * hv[j].y) + (hv[j].z * hv[j].z + hv[j].w * hv[j].w); }
        const float rs = 1.0f / sqrtf(wave_sum(ss9) * (1.0f / 1024.0f) + EPS);
#pragma unroll
        for (int j = 0; j < 4; ++j) { f32x4 v = hv[j]; const f32x4 g = *(const f32x4*)(args.in[22] + 4 * lane + 256 * j);
            v = v * rs * g;
#ifdef TSEL
            if (row == 0 && lane == 0 && j == 0) { v.x += tsD; v.y += tsD2; }
#endif
            *(f32x4*)(hr + 4 * lane + 256 * j) = v; }
    }
}

#undef ws
#undef out
#undef H
extern "C" void kernel_launch(void* const* d_in, const int* in_sizes, int n_in, void* d_out, int out_size, void* d_ws, size_t ws_size, hipStream_t stream) {
    static int grid = 0;
    if (grid == 0) {
        if (n_in != 23 || (size_t)out_size != O_END || ws_size < WS_END) { fprintf(stderr, "kernel_launch: unexpected shapes n_in %d out %d ws %zu\n", n_in, out_size, ws_size); grid = -1; return; }
        int dev = 0, cus = 0, per_cu = 0;
        hipGetDevice(&dev); hipDeviceGetAttribute(&cus, hipDeviceAttributeMultiprocessorCount, dev);
        if (hipFuncSetAttribute((const void*)mega_fwd, hipFuncAttributeMaxDynamicSharedMemorySize, LDS_BYTES) != hipSuccess) { fprintf(stderr, "kernel_launch: hipFuncSetAttribute failed\n"); grid = -1; return; }
        hipOccupancyMaxActiveBlocksPerMultiprocessor(&per_cu, (const void*)mega_fwd, 512, LDS_BYTES);
        (void)hipGetLastError();
        if (per_cu < 1) per_cu = 1;
        grid = cus;
        if (grid <= 0) grid = 256;
    }
    if (grid < 0) return;
    hipMemsetAsync((char*)d_ws + WS_CTL, 0, 64 * 1024, stream);
    Args a{};
    for (int i = 0; i < 23; ++i) a.in[i] = (const float*)d_in[i];
    a.out = (float*)d_out; a.ws = (unsigned char*)d_ws;
    for (int i = 0; i < 32; ++i) a.invf[i] = std::pow(10000.0, -(double)i / 32.0);
    void* kargs[] = {&a};
    hipError_t e = hipLaunchCooperativeKernel((const void*)mega_fwd, dim3(grid), dim3(512), kargs, LDS_BYTES, stream);
    if (e != hipSuccess) fprintf(stderr, "cooperative launch failed: %s (grid %d)\n", hipGetErrorString(e), grid);
}
```
